# Optimizing an MI355X kernel written in HIP

```python
import jax, jax.numpy as jnp
from jax import lax
import numpy as np


D_MODEL = 1024
BATCH = 2
SEQ = 8192
DEPTH = 1

N_HEADS_A = 8
N_HEADS_B = 8
HEAD_DIM = 64
ROPE_DIM = HEAD_DIM // 4
NOPE_DIM = HEAD_DIM - ROPE_DIM
KV_RANK = 128
IDX_HEADS = 8
IDX_DIM = 64
IDX_TOPK = 256
MOBA_BLOCK = 256
MOBA_TOPK = 3
Q_BLOCK = 128
D_FF = 2816
ROPE_THETA = 500000.0
EPS = 1e-6
N_MOD = 9
WIDTH_A = N_HEADS_A * HEAD_DIM
WIDTH_B = N_HEADS_B * HEAD_DIM
IN_SPLITS = (WIDTH_A, KV_RANK, ROPE_DIM, IDX_HEADS * IDX_DIM, IDX_DIM, IDX_HEADS, WIDTH_B, WIDTH_B, WIDTH_B, D_MODEL, D_MODEL)
IN_COLS = sum(IN_SPLITS)

kernel_name = 'hybrid_dsa_moba_macaron_adaln'


def rms_norm(x, g):
    xf = x.astype(jnp.float32)
    y = xf * lax.rsqrt(jnp.mean(xf * xf, axis=-1, keepdims=True) + EPS)
    return (y * g.astype(jnp.float32)).astype(x.dtype)


def modulate(h, shift, scale):
    return h * (1.0 + scale) + shift


def partial_rotary(x, pos):
    half = ROPE_DIM // 2
    inv_freq = jnp.power(ROPE_THETA, -jnp.arange(half, dtype=jnp.float32) / half)
    ang = pos.astype(jnp.float32)[..., None] * inv_freq
    if x.ndim == 4:
        ang = ang[:, :, None, :]
    cos, sin = jnp.cos(ang), jnp.sin(ang)
    xr = x[..., :ROPE_DIM].astype(jnp.float32)
    x1, x2 = xr[..., :half], xr[..., half:]
    rot = jnp.concatenate([x1 * cos - x2 * sin, x2 * cos + x1 * sin], axis=-1).astype(x.dtype)
    return jnp.concatenate([rot, x[..., ROPE_DIM:]], axis=-1)


def swiglu(h, w_in, w_out):
    a, b = jnp.split(h @ w_in, 2, axis=-1)
    return (jax.nn.silu(a) * b) @ w_out


def dsa_attention(q_a, ckv, k_rope, q_idx, k_idx, w_idx, w_uk, w_uv):
    B, S = q_a.shape[0], q_a.shape[1]
    top_k = min(IDX_TOPK, S // 4)
    key_pos = jnp.arange(S)
    k_idx32 = k_idx.astype(jnp.float32)
    b_ix = jnp.arange(B)[:, None, None]

    def block(i):
        start = i * Q_BLOCK
        q_pos = start + jnp.arange(Q_BLOCK)
        qi = lax.dynamic_slice_in_dim(q_idx, start, Q_BLOCK, axis=1).astype(jnp.float32)
        wi = lax.dynamic_slice_in_dim(w_idx, start, Q_BLOCK, axis=1).astype(jnp.float32)
        qa = lax.dynamic_slice_in_dim(q_a, start, Q_BLOCK, axis=1)
        logits = jnp.einsum('bqhd,bsd->bqhs', qi, k_idx32) * IDX_DIM ** -0.5
        score = jnp.einsum('bqh,bqhs->bqs', wi * IDX_HEADS ** -0.5, jax.nn.relu(logits))
        causal = key_pos[None, :] <= q_pos[:, None]
        score = jnp.where(causal[None], score, -jnp.inf)
        _, sel = lax.top_k(score, top_k)
        valid = sel <= q_pos[None, :, None]
        c_sel = ckv[b_ix, sel]
        r_sel = k_rope[b_ix, sel]
        q_lat = jnp.einsum('bqhn,rhn->bqhr', qa[..., ROPE_DIM:], w_uk)
        s = (jnp.einsum('bqhr,bqkr->bhqk', q_lat, c_sel)
             + jnp.einsum('bqhe,bqke->bhqk', qa[..., :ROPE_DIM], r_sel)) * HEAD_DIM ** -0.5
        s = jnp.where(valid[:, None], s.astype(jnp.float32), -jnp.inf)
        p = jax.nn.softmax(s, axis=-1).astype(c_sel.dtype)
        o_lat = jnp.einsum('bhqk,bqkr->bqhr', p, c_sel)
        return jnp.einsum('bqhr,rhd->bqhd', o_lat, w_uv)

    out = lax.map(block, jnp.arange(S // Q_BLOCK))
    return out.transpose(1, 0, 2, 3, 4).reshape(B, S, WIDTH_A)


def moba_attention(q, k, v):
    B, S, H, Dh = q.shape
    n_kb = -(-S // MOBA_BLOCK)
    pad = n_kb * MOBA_BLOCK - S

    def to_blocks(t):
        t = jnp.pad(t, ((0, 0), (0, pad), (0, 0), (0, 0)))
        return t.reshape(B, n_kb, MOBA_BLOCK, H, Dh).transpose(0, 3, 1, 2, 4)

    k_blk, v_blk = to_blocks(k), to_blocks(v)
    k_mean = jnp.mean(k_blk.astype(jnp.float32), axis=3).astype(q.dtype)
    n_sel = min(MOBA_TOPK, n_kb - 1)
    q_t = q.transpose(0, 2, 1, 3)
    b_ix = jnp.arange(B)[:, None, None, None]
    h_ix = jnp.arange(H)[None, :, None, None]
    blk_ids = jnp.arange(n_kb)
    scale = Dh ** -0.5

    def block(i):
        start = i * Q_BLOCK
        q_pos = start + jnp.arange(Q_BLOCK)
        own = start // MOBA_BLOCK
        qc = lax.dynamic_slice_in_dim(q_t, start, Q_BLOCK, axis=2)
        k_own = lax.dynamic_index_in_dim(k_blk, own, axis=2, keepdims=False)
        v_own = lax.dynamic_index_in_dim(v_blk, own, axis=2, keepdims=False)
        own_pos = own * MOBA_BLOCK + jnp.arange(MOBA_BLOCK)
        s_own = jnp.einsum('bhqd,bhkd->bhqk', qc, k_own).astype(jnp.float32) * scale
        s_own = jnp.where(own_pos[None, :] <= q_pos[:, None], s_own, -jnp.inf)
        if n_sel == 0:
            p = jax.nn.softmax(s_own, axis=-1).astype(v_own.dtype)
            return jnp.einsum('bhqk,bhkd->bhqd', p, v_own)
        gate = jnp.einsum('bhqd,bhnd->bhqn', qc, k_mean).astype(jnp.float32)
        gate = jnp.where(blk_ids < own, gate, -jnp.inf)
        _, sel = lax.top_k(gate, n_sel)
        sel_valid = sel < own
        k_sel = k_blk[b_ix, h_ix, sel]
        v_sel = v_blk[b_ix, h_ix, sel]
        s_sel = jnp.einsum('bhqd,bhqnkd->bhqnk', qc, k_sel).astype(jnp.float32) * scale
        s_sel = jnp.where(sel_valid[..., None], s_sel, -jnp.inf)
        s = jnp.concatenate([s_sel.reshape(B, H, Q_BLOCK, n_sel * MOBA_BLOCK), s_own], axis=-1)
        p = jax.nn.softmax(s, axis=-1).astype(v_own.dtype)
        p_sel = p[..., :n_sel * MOBA_BLOCK].reshape(B, H, Q_BLOCK, n_sel, MOBA_BLOCK)
        p_own = p[..., n_sel * MOBA_BLOCK:]
        return (jnp.einsum('bhqnk,bhqnkd->bhqd', p_sel, v_sel)
                + jnp.einsum('bhqk,bhkd->bhqd', p_own, v_own))

    out = lax.map(block, jnp.arange(S // Q_BLOCK))
    return out.transpose(1, 0, 3, 2, 4).reshape(B, S, H * Dh)


def hybrid_mixer(h, pos, w_in, kv_norm_g, w_uk, w_uv, w_branch_a, w_branch_b, w_out):
    B, S, _ = h.shape
    proj = h @ w_in
    (q_a, ckv, k_rope, q_idx, k_idx, w_idx, q_b, k_b, v_b, gate_a, gate_b) = jnp.split(
        proj, np.cumsum(IN_SPLITS)[:-1].tolist(), axis=-1)
    q_a = partial_rotary(q_a.reshape(B, S, N_HEADS_A, HEAD_DIM), pos)
    ckv = rms_norm(ckv, kv_norm_g)
    k_rope = partial_rotary(k_rope, pos)
    q_idx = partial_rotary(q_idx.reshape(B, S, IDX_HEADS, IDX_DIM), pos)
    k_idx = partial_rotary(k_idx, pos)
    o_a = dsa_attention(q_a, ckv, k_rope, q_idx, k_idx, w_idx, w_uk, w_uv)
    q_b = partial_rotary(q_b.reshape(B, S, N_HEADS_B, HEAD_DIM), pos)
    k_b = partial_rotary(k_b.reshape(B, S, N_HEADS_B, HEAD_DIM), pos)
    v_b = v_b.reshape(B, S, N_HEADS_B, HEAD_DIM)
    o_b = moba_attention(q_b, k_b, v_b)
    y = jax.nn.sigmoid(gate_a) * (o_a @ w_branch_a) + jax.nn.sigmoid(gate_b) * (o_b @ w_branch_b)
    return y @ w_out


def setup_inputs(seed: int = 0) -> dict:
    key = jax.random.key(seed)
    ks = jax.random.split(key, 20)

    def nrm(k, shape, scale):
        return jax.random.normal(k, shape, jnp.float32) * scale

    return {
        'x': nrm(ks[0], (BATCH, SEQ, D_MODEL), 1.0),
        'c': nrm(ks[1], (BATCH, D_MODEL), 1.0),
        'positions': jnp.tile(jnp.arange(SEQ, dtype=jnp.int32)[None, :], (BATCH, 1)),
        'ada_w': nrm(ks[2], (DEPTH, D_MODEL, N_MOD * D_MODEL), D_MODEL ** -0.5),
        'ada_b': nrm(ks[3], (DEPTH, N_MOD * D_MODEL), 0.02),
        'norm1_g': 1.0 + nrm(ks[4], (DEPTH, D_MODEL), 0.05),
        'ffn1_w_in': nrm(ks[5], (DEPTH, D_MODEL, 2 * D_FF), D_MODEL ** -0.5),
        'ffn1_w_out': nrm(ks[6], (DEPTH, D_FF, D_MODEL), D_FF ** -0.5),
        'norm2_g': 1.0 + nrm(ks[7], (DEPTH, D_MODEL), 0.05),
        'w_in': nrm(ks[8], (DEPTH, D_MODEL, IN_COLS), D_MODEL ** -0.5),
        'kv_norm_g': 1.0 + nrm(ks[9], (DEPTH, KV_RANK), 0.05),
        'w_uk': nrm(ks[10], (DEPTH, KV_RANK, N_HEADS_A, NOPE_DIM), KV_RANK ** -0.5),
        'w_uv': nrm(ks[11], (DEPTH, KV_RANK, N_HEADS_A, HEAD_DIM), KV_RANK ** -0.5),
        'w_branch_a': nrm(ks[12], (DEPTH, WIDTH_A, D_MODEL), WIDTH_A ** -0.5),
        'w_branch_b': nrm(ks[13], (DEPTH, WIDTH_B, D_MODEL), WIDTH_B ** -0.5),
        'w_out': nrm(ks[14], (DEPTH, D_MODEL, D_MODEL), D_MODEL ** -0.5),
        'norm3_g': 1.0 + nrm(ks[15], (DEPTH, D_MODEL), 0.05),
        'ffn2_w_in': nrm(ks[16], (DEPTH, D_MODEL, 2 * D_FF), D_MODEL ** -0.5),
        'ffn2_w_out': nrm(ks[17], (DEPTH, D_FF, D_MODEL), D_FF ** -0.5),
        'final_g': 1.0 + nrm(ks[18], (D_MODEL,), 0.05),
    }


def reference(x, c, positions, ada_w, ada_b, norm1_g, ffn1_w_in, ffn1_w_out, norm2_g, w_in,
              kv_norm_g, w_uk, w_uv, w_branch_a, w_branch_b, w_out, norm3_g, ffn2_w_in,
              ffn2_w_out, final_g):
    B = x.shape[0]
    c_act = jax.nn.silu(c)
    for l in range(DEPTH):
        mod = (c_act @ ada_w[l] + ada_b[l]).reshape(B, N_MOD, 1, D_MODEL)
        sh1, sc1, g1 = mod[:, 0], mod[:, 1], mod[:, 2]
        sh2, sc2, g2 = mod[:, 3], mod[:, 4], mod[:, 5]
        sh3, sc3, g3 = mod[:, 6], mod[:, 7], mod[:, 8]
        h = modulate(rms_norm(x, norm1_g[l]), sh1, sc1)
        x = x + 0.5 * g1 * swiglu(h, ffn1_w_in[l], ffn1_w_out[l])
        h = modulate(rms_norm(x, norm2_g[l]), sh2, sc2)
        x = x + g2 * hybrid_mixer(h, positions, w_in[l], kv_norm_g[l], w_uk[l], w_uv[l],
                                  w_branch_a[l], w_branch_b[l], w_out[l])
        h = modulate(rms_norm(x, norm3_g[l]), sh3, sc3)
        x = x + 0.5 * g3 * swiglu(h, ffn2_w_in[l], ffn2_w_out[l])
    return rms_norm(x, final_g)
```

```cpp
#include <hip/hip_runtime.h>
#include <cstdio>
#include <cstdint>
namespace pg8 {
#define PG8_LAS __attribute__((address_space(3)))
typedef unsigned short h16_t;
typedef _Float16 f16x8 __attribute__((ext_vector_type(8)));
typedef float f32x4 __attribute__((ext_vector_type(4)));
typedef unsigned u32x4 __attribute__((ext_vector_type(4)));
constexpr int BM = 256, BK = 64, HALF = 128, HTB = HALF * BK * 2  , STAGE_BYTES = 8 * HTB, NXCD = 8, WGM = 8;

__host__ __device__ __forceinline__ int lds_byte(int r, int c) { const int st = (r >> 4) * 2 + (c >> 5), rr = r & 15, cc = c & 31, ob = rr * 64 + cc * 2; return st * 1024 + (ob ^ (((ob >> 9) & 1) << 5)); }
__host__ __device__ __forceinline__ void stage_rc(int b, int& R, int& C) { const int st = b / 1024, sb = b % 1024, swz = sb ^ (((sb >> 9) & 1) << 5); R = (st >> 1) * 16 + swz / 64; C = (st & 1) * 32 + (swz % 64) / 2; }
__host__ __device__ __forceinline__ int perm32(int rho) { const int n = rho >> 4, i = rho & 15; return 8 * (i >> 2) + 4 * n + (i & 3); }

struct Unit { int pm, pn; };
struct Gemm { const h16_t* A; const h16_t* Bt; int M, N, K; };

struct StaticOrder {
    int nM, nN, nwg, G, c;
    __host__ __device__ void init(int M, int N, int G_, int c_) { nM = M / BM; nN = N / BM; nwg = nM * nN; G = G_; c = c_; }
    __host__ __device__ bool next(int i, Unit& u) const {
        const long L = (long)i * G + c; if (L >= nwg) return false;
        int wgid = (int)L; { const int q = nwg / NXCD, r = nwg % NXCD, xcd = wgid % NXCD, off = wgid / NXCD; wgid = (xcd < r ? xcd * (q + 1) : r * (q + 1) + (xcd - r) * q) + off; }
        const int nig = WGM * nN, gid = wgid / nig, fm = gid * WGM, gsz = (nM - fm) < WGM ? (nM - fm) : WGM;
        u.pm = fm + ((wgid % nig) % gsz); u.pn = (wgid % nig) / gsz; return true;
    }
    __device__ __forceinline__ void a_ready(const Unit&) const {}
    __device__ __forceinline__ void done(const Unit&) const {}
};


template <class Epi, class Sched, bool ALIGN_EPI = false, bool SP2 = false>
__device__ __forceinline__ void gemm_phase(PG8_LAS unsigned char* lds, const Gemm g, const Sched& S, const Epi& E) {
    const int tid = threadIdx.x, wid = __builtin_amdgcn_readfirstlane(tid >> 6), lane = tid & 63, wr = wid >> 2, wc = wid & 3, fr = lane & 15, fq = lane >> 4;
    const int K = g.K, nt = K / BK;
    unsigned voffA[2], voffB[2];
#pragma unroll
    for (int i = 0; i < 2; ++i) { int R, C; stage_rc(tid * 16 + i * 8192, R, C); const int Rb = Epi::PERM ? ((R & ~31) + perm32(R & 31)) : R;
        voffA[i] = (unsigned)(R * K + C) * 2u; voffB[i] = (unsigned)(Rb * K + C) * 2u; }
    const size_t kstep = (size_t)(BK * 2);
    const size_t hstep = (size_t)HALF * K * 2;
    const size_t tstep = 2 * hstep;
    const unsigned ldsw = (unsigned)wid * 1024u;
    const int aoff = lds_byte(wr * 64 + fr, fq * 8), boff = lds_byte(wc * 32 + fr, fq * 8);
#define PG8_SA(b, h) (((b) * 2 + (h)) * HTB)
#define PG8_SB(b, h) ((4 + (b) * 2 + (h)) * HTB)
#define PG8_STAGE(bufoff, gbase, voff) do { _Pragma("unroll") for (int _i = 0; _i < 2; ++_i) \
        __builtin_amdgcn_global_load_lds((const unsigned*)((const char*)(gbase) + (voff)[_i]), (PG8_LAS unsigned*)(lds + (bufoff) + ldsw + _i * 8192), 16, 0, 0); } while (0)
#define PG8_LDA(dst, b, h) do { _Pragma("unroll") for (int m = 0; m < 4; ++m) _Pragma("unroll") for (int k = 0; k < 2; ++k) dst[m][k] = *(const PG8_LAS f16x8*)(lds + PG8_SA(b, h) + aoff + m * 2048 + k * 1024); } while (0)
#define PG8_LDB(dst, b, h) do { _Pragma("unroll") for (int n = 0; n < 2; ++n) _Pragma("unroll") for (int k = 0; k < 2; ++k) dst[n][k] = *(const PG8_LAS f16x8*)(lds + PG8_SB(b, h) + boff + n * 2048 + k * 1024); } while (0)
#define PG8_MMA(ai, bj, At, Bt) do { __builtin_amdgcn_s_setprio(1); _Pragma("unroll") for (int m = 0; m < 4; ++m) _Pragma("unroll") for (int n = 0; n < 2; ++n) _Pragma("unroll") for (int k = 0; k < 2; ++k) \
        acc[ai][bj][m][n] = __builtin_amdgcn_mfma_f32_16x16x32_f16(Bt[n][k], At[m][k], acc[ai][bj][m][n], 0, 0, 0); __builtin_amdgcn_s_setprio(0); } while (0)
#define PG8_WAIT_V(n) asm volatile("s_waitcnt vmcnt(" #n ")" ::: "memory")
#define PG8_WAIT_L(n) asm volatile("s_waitcnt lgkmcnt(" #n ")" ::: "memory")
#define PG8_BAR __builtin_amdgcn_s_barrier()
#define PG8_SCHED __builtin_amdgcn_sched_barrier(0)
    Unit cur, nxt; int ui = 0;
    if (!S.next(0, cur)) return;
    f32x4 acc[2][2][4][2];
#pragma unroll
    for (int a = 0; a < 2; ++a)
#pragma unroll
        for (int b = 0; b < 2; ++b)
#pragma unroll
            for (int m = 0; m < 4; ++m)
#pragma unroll
                for (int n = 0; n < 2; ++n) acc[a][b][m][n] = (f32x4){0.f, 0.f, 0.f, 0.f};
    f16x8 At[4][2], B0[2][2], B1[2][2];
    const char* cA = (const char*)g.A + (size_t)cur.pm * tstep; const char* cB = (const char*)g.Bt + (size_t)cur.pn * tstep;
    S.a_ready(cur);
    if constexpr (SP2) {
        PG8_STAGE(PG8_SB(0, 0), cB, voffB); PG8_STAGE(PG8_SB(0, 1), cB + hstep, voffB); PG8_STAGE(PG8_SA(0, 0), cA, voffA); PG8_STAGE(PG8_SA(0, 1), cA + hstep, voffA);
        if (wr == 1) PG8_BAR;
        PG8_WAIT_V(2); PG8_BAR;
        PG8_STAGE(PG8_SB(1, 0), cB + kstep, voffB); PG8_STAGE(PG8_SA(1, 0), cA + kstep, voffA); PG8_STAGE(PG8_SB(1, 1), cB + hstep + kstep, voffB);
        PG8_WAIT_V(6); PG8_BAR;
    } else {
        PG8_STAGE(PG8_SB(0, 0), cB, voffB); PG8_STAGE(PG8_SA(0, 0), cA, voffA); PG8_STAGE(PG8_SB(0, 1), cB + hstep, voffB); PG8_STAGE(PG8_SA(0, 1), cA + hstep, voffA);
        if (wr == 1) PG8_BAR;
        PG8_WAIT_V(4); PG8_BAR;
        PG8_STAGE(PG8_SB(1, 0), cB + kstep, voffB); PG8_STAGE(PG8_SA(1, 0), cA + kstep, voffA); PG8_STAGE(PG8_SB(1, 1), cB + hstep + kstep, voffB);
        PG8_WAIT_V(6); PG8_BAR;
    }
    for (;;) {
        const bool has_next = S.next(ui + 1, nxt);
        const char* nA = has_next ? (const char*)g.A + (size_t)nxt.pm * tstep : cA; const char* nB = has_next ? (const char*)g.Bt + (size_t)nxt.pn * tstep : cB;
        for (int t = 0; t < nt; t += 2) {
            const bool last = (t == nt - 2);
            const char* a1 = cA + (size_t)(t + 1) * kstep;
            const char* a2 = last ? nA : cA + (size_t)(t + 2) * kstep; const char* b2 = last ? nB : cB + (size_t)(t + 2) * kstep;
            const char* a3 = a2 + kstep; const char* b3 = b2 + kstep;
            if (last && has_next) S.a_ready(nxt);
            if constexpr (SP2) {
            PG8_LDB(B0, 0, 0); PG8_LDB(B1, 0, 1); PG8_SCHED; PG8_LDA(At, 0, 0); PG8_STAGE(PG8_SA(1, 1), a1 + hstep, voffA);
            PG8_WAIT_V(8); PG8_WAIT_L(0); PG8_BAR; PG8_MMA(0, 0, At, B0); PG8_MMA(0, 1, At, B1); PG8_BAR; PG8_SCHED;
            PG8_LDA(At, 0, 1); PG8_STAGE(PG8_SB(0, 0), b2, voffB); PG8_STAGE(PG8_SB(0, 1), b2 + hstep, voffB); PG8_STAGE(PG8_SA(0, 0), a2, voffA);
            PG8_WAIT_V(8); PG8_WAIT_L(0); PG8_BAR; PG8_MMA(1, 0, At, B0); PG8_MMA(1, 1, At, B1); PG8_BAR; PG8_SCHED;
            PG8_LDB(B0, 1, 0); PG8_LDB(B1, 1, 1); PG8_SCHED; PG8_LDA(At, 1, 0); PG8_STAGE(PG8_SA(0, 1), a2 + hstep, voffA);
            PG8_WAIT_V(8); PG8_WAIT_L(0); PG8_BAR; PG8_MMA(0, 0, At, B0); PG8_MMA(0, 1, At, B1); PG8_BAR; PG8_SCHED;
            PG8_LDA(At, 1, 1); PG8_STAGE(PG8_SB(1, 0), b3, voffB); PG8_STAGE(PG8_SB(1, 1), b3 + hstep, voffB); PG8_STAGE(PG8_SA(1, 0), a3, voffA);
            PG8_WAIT_V(8); PG8_WAIT_L(0); PG8_BAR; PG8_MMA(1, 0, At, B0); PG8_MMA(1, 1, At, B1); PG8_BAR; PG8_SCHED;
            } else {
            PG8_LDB(B0, 0, 0); PG8_SCHED; PG8_LDA(At, 0, 0); PG8_STAGE(PG8_SA(1, 1), a1 + hstep, voffA);
            PG8_WAIT_L(8); PG8_BAR; PG8_WAIT_L(0); PG8_MMA(0, 0, At, B0); PG8_BAR; PG8_SCHED;
            PG8_LDB(B1, 0, 1); PG8_STAGE(PG8_SB(0, 0), b2, voffB);
            PG8_BAR; PG8_WAIT_L(0); PG8_MMA(0, 1, At, B1); PG8_BAR;
            PG8_LDA(At, 0, 1); PG8_STAGE(PG8_SA(0, 0), a2, voffA);
            PG8_BAR; PG8_WAIT_L(0); PG8_MMA(1, 0, At, B0); PG8_BAR; PG8_SCHED;
            PG8_STAGE(PG8_SB(0, 1), b2 + hstep, voffB);
            PG8_WAIT_V(6); PG8_BAR; PG8_MMA(1, 1, At, B1); PG8_BAR;
            PG8_LDB(B0, 1, 0); PG8_SCHED; PG8_LDA(At, 1, 0); PG8_STAGE(PG8_SA(0, 1), a2 + hstep, voffA);
            PG8_WAIT_L(8); PG8_BAR; PG8_WAIT_L(0); PG8_MMA(0, 0, At, B0); PG8_BAR; PG8_SCHED;
            PG8_LDB(B1, 1, 1); PG8_STAGE(PG8_SB(1, 0), b3, voffB);
            PG8_BAR; PG8_WAIT_L(0); PG8_MMA(0, 1, At, B1); PG8_BAR;
            PG8_LDA(At, 1, 1); PG8_STAGE(PG8_SA(1, 0), a3, voffA);
            PG8_BAR; PG8_WAIT_L(0); PG8_MMA(1, 0, At, B0); PG8_BAR; PG8_SCHED;
            PG8_STAGE(PG8_SB(1, 1), b3 + hstep, voffB);
            PG8_WAIT_V(6); PG8_BAR; PG8_MMA(1, 1, At, B1); PG8_BAR;
            }
        }
        if constexpr (ALIGN_EPI) { if (wr == 0) PG8_BAR; }
        if constexpr (!Epi::AFTER_DRAIN) { E(acc, cur, wr, wc, fr, fq); S.done(cur); }
        if (!has_next) break;
#pragma unroll
        for (int a = 0; a < 2; ++a)
#pragma unroll
            for (int b = 0; b < 2; ++b)
#pragma unroll
                for (int m = 0; m < 4; ++m)
#pragma unroll
                    for (int n = 0; n < 2; ++n) acc[a][b][m][n] = (f32x4){0.f, 0.f, 0.f, 0.f};
        cur = nxt; cA = nA; cB = nB; ++ui;
        if constexpr (ALIGN_EPI) { if (wr == 1) PG8_BAR; }
    }
    PG8_WAIT_V(0);
    if constexpr (!ALIGN_EPI) { if (wr == 0) PG8_BAR; }
    PG8_BAR;
    if constexpr (Epi::AFTER_DRAIN) { E.fused(acc, cur, wr, wc, fr, fq, lds, wid, lane); S.done(cur); }
#undef PG8_SA
#undef PG8_SB
#undef PG8_STAGE
#undef PG8_LDA
#undef PG8_LDB
#undef PG8_MMA
#undef PG8_WAIT_V
#undef PG8_WAIT_L
#undef PG8_BAR
#undef PG8_SCHED
}
}
constexpr int BATCH = 2, SEQ = 8192, DM = 1024, MTOK = BATCH * SEQ;
constexpr int DFF = 2816, NMODV = 9 * DM;
constexpr int NPROJ = 22 * 256;
constexpr int NWAVES = 8;
constexpr float EPS_F = 1e-6f;
constexpr float C2F = 0.18033688011112042f;
#ifndef MK_SPLIT
#define MK_SPLIT 0
#endif
constexpr int N_PHASES = 13;

constexpr size_t KiB = 1024, MiB = 1u << 20;
constexpr size_t WS_CTL = 0, CTL_ZERO_BYTES = 256 * KiB;
constexpr size_t WS_KMEAN = 64 * KiB;
constexpr size_t WS_MOD = 256 * KiB;
constexpr size_t WS_ROPE = 512 * KiB;
constexpr size_t WS_W1A = 2 * MiB, WS_W1B = 13 * MiB, WS_W2A = 19 * MiB, WS_W2B = 30 * MiB, WS_WIN = 36 * MiB, WS_WBA = 47 * MiB, WS_WBB = 49 * MiB, WS_WO = 50 * MiB;
constexpr size_t WS_XN = 52 * MiB;
constexpr size_t WS_H = 84 * MiB;
constexpr size_t WS_QLAT = 84 * MiB, WS_QB = 116 * MiB, WS_KB = 132 * MiB, WS_VB = 148 * MiB, WS_QIDX = 164 * MiB, WS_CKVR = 180 * MiB, WS_QR = 185 * MiB,
                 WS_KIDX = 189 * MiB, WS_WIDX = 191 * MiB, WS_GA = 192 * MiB, WS_GB = 224 * MiB, WS_END = 256 * MiB;
constexpr size_t WS_Y = WS_KB;
static_assert(WS_W1B - WS_W1A >= (size_t)2 * DFF * DM * 2 && WS_W2A - WS_W1B >= (size_t)DM * DFF * 2 && WS_WIN - WS_W2B >= (size_t)DM * DFF * 2 && WS_WBA - WS_WIN >= (size_t)NPROJ * DM * 2, "weights map");
static_assert(WS_H + (size_t)MTOK * DFF * 2 <= WS_END && WS_CKVR + (size_t)MTOK * 320 <= WS_QR && WS_QR + (size_t)MTOK * 256 <= WS_KIDX && WS_KIDX + (size_t)MTOK * 128 <= WS_WIDX, "act map");
constexpr int CW_TMO = 0, CW_CODE = 1, CW_BAR = 4096;

constexpr int RING_OFF = 0, RING_BYTES = 131072;
constexpr int LDSCTL_OFF = RING_BYTES, MISC_OFF = LDSCTL_OFF + 320;
constexpr int XS_OFF = RING_BYTES + 1024, XS_BYTES = 16384;
constexpr int LDS_BYTES = 155648;

#define GAS __attribute__((address_space(1)))
#define LAS __attribute__((address_space(3)))
typedef unsigned short h16;
typedef unsigned v4u __attribute__((ext_vector_type(4)));
typedef unsigned v2u __attribute__((ext_vector_type(2)));
typedef float f32x4 __attribute__((ext_vector_type(4)));
typedef float f32x2 __attribute__((ext_vector_type(2)));
typedef _Float16 f16x2 __attribute__((ext_vector_type(2)));
typedef _Float16 f16x8 __attribute__((ext_vector_type(8)));
typedef GAS unsigned gu32;
typedef GAS unsigned long long gu64;
#define RLX_AGENT __ATOMIC_RELAXED, __HIP_MEMORY_SCOPE_AGENT
#define LDS_WAIT() asm volatile("s_waitcnt lgkmcnt(0)" ::: "memory")
#define VM_WAIT() asm volatile("s_waitcnt vmcnt(0)" ::: "memory")
__device__ __forceinline__ unsigned pkh(float lo, float hi) { f32x2 v = {lo, hi}; f16x2 h = __builtin_convertvector(v, f16x2); return __builtin_bit_cast(unsigned, h); }
__device__ __forceinline__ float h2f(h16 b) { return (float)__builtin_bit_cast(_Float16, b); }
__device__ __forceinline__ float silu_f(float a) { return a * __builtin_amdgcn_rcpf(1.0f + __builtin_amdgcn_exp2f(-1.4426950408889634f * a)); }
__device__ __forceinline__ float sigm_f(float a) { return __builtin_amdgcn_rcpf(1.0f + __builtin_amdgcn_exp2f(-1.4426950408889634f * a)); }
#define XB_TMO      128
#define XB_XCNT(j)  (256  + 64 * (j))
#define XB_XSUB(j)  (1280 + 64 * (j))
#define XB_XGEN(j)  (2304 + 64 * (j))
#define XB_TOP      3328
#define XB_TOPGEN   3392
#define XCD_BAR_WORDS 3456
#define XB_SPIN_CAP (1u << 18)

__device__ __forceinline__ unsigned xb_ld(unsigned* p)              { return __hip_atomic_load(p, __ATOMIC_RELAXED, __HIP_MEMORY_SCOPE_AGENT); }
__device__ __forceinline__ unsigned xb_add(unsigned* p, unsigned v) { return __hip_atomic_fetch_add(p, v, __ATOMIC_RELAXED, __HIP_MEMORY_SCOPE_AGENT); }
__device__ __forceinline__ unsigned xb_xcc_id() { return (unsigned)__builtin_amdgcn_s_getreg((3 << 11) | 20) & 0xFu; }
#define XB_SPIN(cond, bar) do { unsigned _sp = 0; while (cond) { __builtin_amdgcn_s_sleep(1); \
    if ((++_sp & 255u) == 0u) { if (xb_ld(&(bar)[XB_TMO])) break; if (_sp > XB_SPIN_CAP) { atomicAdd(&(bar)[XB_TMO], 1u); break; } } } } while (0)

struct XcdBarrier {
    unsigned* bar; unsigned x;
    volatile LAS unsigned* st;
};

__device__ __forceinline__ XcdBarrier xcd_barrier_post(unsigned* bar, volatile LAS unsigned* st) {
    XcdBarrier b; b.bar = bar; b.x = xb_xcc_id(); b.st = st;
    if (threadIdx.x == 0) (void)xb_add(&bar[XB_XCNT(b.x)], 1u);
    return b;
}
__device__ __forceinline__ void xcd_barrier_complete(unsigned* bar, unsigned x, unsigned& nloc, unsigned& nx) {
    const unsigned G = gridDim.x * gridDim.y * gridDim.z;
    unsigned sum, cnt, mine, sp = 0u;
    for (;;) {
        sum = 0u; cnt = 0u; mine = 0u;
#pragma unroll
        for (unsigned j = 0; j < 16; ++j) { const unsigned c = xb_ld(&bar[XB_XCNT(j)]); sum += c; cnt += (c > 0u) ? 1u : 0u; mine = (j == x) ? c : mine; }
        if (sum == G) break;
        __builtin_amdgcn_s_sleep(1);
        if ((++sp & 255u) == 0u) { if (xb_ld(&bar[XB_TMO])) break; if (sp > XB_SPIN_CAP) { atomicAdd(&bar[XB_TMO], 1u); break; } }
    }
    nloc = mine > 0u ? mine : 1u; nx = cnt > 0u ? cnt : 1u;
}

__device__ __forceinline__ void xcd_barrier(const XcdBarrier& b) {
    asm volatile("s_waitcnt vmcnt(0)" ::: "memory");
    __syncthreads();
    if (threadIdx.x == 0) {
        unsigned* bar = b.bar;
        __builtin_amdgcn_s_waitcnt(0);
        unsigned nloc = b.st[0], nx = b.st[1];
        if (nloc == 0u) { xcd_barrier_complete(bar, b.x, nloc, nx); b.st[0] = nloc; b.st[1] = nx; }
        const unsigned old = xb_add(&bar[XB_XSUB(b.x)], 1u);
        const unsigned gen = old / nloc;
        if (old + 1u == (gen + 1u) * nloc) {
            __builtin_amdgcn_fence(__ATOMIC_RELEASE, "agent");
            asm volatile("s_waitcnt vmcnt(0)" ::: "memory");
            const unsigned og = xb_add(&bar[XB_TOP], 1u);
            const unsigned tg = og / nx;
            if (og + 1u == (tg + 1u) * nx) xb_add(&bar[XB_TOPGEN], 1u);
            else XB_SPIN(xb_ld(&bar[XB_TOPGEN]) == tg, bar);
            __builtin_amdgcn_fence(__ATOMIC_ACQUIRE, "agent");
            xb_add(&bar[XB_XGEN(b.x)], 1u);
            asm volatile("s_waitcnt vmcnt(0)" ::: "memory");
        } else {
            XB_SPIN(xb_ld(&bar[XB_XGEN(b.x)]) == gen, bar);
            __builtin_amdgcn_fence(__ATOMIC_ACQUIRE, "agent");
            asm volatile("s_waitcnt vmcnt(0)" ::: "memory");
        }
    }
    __syncthreads();
}
using pg8::Unit;
typedef pg8::f32x4 accv;
struct EpiSwiglu {
    static constexpr bool PERM = true, AFTER_DRAIN = false;
    h16* H;
    __device__ __forceinline__ void operator()(const accv (&acc)[2][2][4][2], const Unit& u, int wr, int wc, int fr, int fq) const {
        const int row0 = u.pm * 256 + wr * 64 + fr, col0 = u.pn * 128 + wc * 32 + 8 * fq;
#pragma unroll
        for (int ai = 0; ai < 2; ++ai)
#pragma unroll
            for (int m = 0; m < 4; ++m) {
                h16* rowp = H + (size_t)(row0 + ai * 128 + m * 16) * DFF + col0;
                const accv a0 = acc[ai][0][m][0], a1 = acc[ai][0][m][1], b0 = acc[ai][1][m][0], b1 = acc[ai][1][m][1];
                v4u w;
                w.x = pkh(silu_f(a0[0]) * b0[0], silu_f(a0[1]) * b0[1]); w.y = pkh(silu_f(a0[2]) * b0[2], silu_f(a0[3]) * b0[3]);
                w.z = pkh(silu_f(a1[0]) * b1[0], silu_f(a1[1]) * b1[1]); w.w = pkh(silu_f(a1[2]) * b1[2], silu_f(a1[3]) * b1[3]);
                *(v4u*)rowp = w;
            }
    }
};
struct EpiResid {
    static constexpr bool PERM = false, AFTER_DRAIN = false;
    const float* base; float* out; const float* gate; float factor;
    __device__ __forceinline__ void operator()(const accv (&acc)[2][2][4][2], const Unit& u, int wr, int wc, int fr, int fq) const {
        const int row0 = u.pm * 256 + wr * 64 + fr, col0 = u.pn * 256 + wc * 32 + 4 * fq, b = (u.pm >= 32) ? 1 : 0;
        accv gv[2][2];
#pragma unroll
        for (int bj = 0; bj < 2; ++bj)
#pragma unroll
            for (int n = 0; n < 2; ++n) gv[bj][n] = *(const accv*)(gate + (size_t)b * NMODV + col0 + bj * 128 + n * 16) * factor;
#pragma unroll
        for (int ai = 0; ai < 2; ++ai)
#pragma unroll
            for (int m = 0; m < 4; ++m) {
                const size_t off = (size_t)(row0 + ai * 128 + m * 16) * DM + col0;
#pragma unroll
                for (int bj = 0; bj < 2; ++bj)
#pragma unroll
                    for (int n = 0; n < 2; ++n) {
                        const accv bs = *(const accv*)(base + off + bj * 128 + n * 16);
                        *(accv*)(out + off + bj * 128 + n * 16) = bs + gv[bj][n] * acc[ai][bj][m][n];
                    }
            }
    }
};
__device__ __forceinline__ v4u pack8(const accv& a, const accv& b) { v4u w; w.x = pkh(a[0], a[1]); w.y = pkh(a[2], a[3]); w.z = pkh(b[0], b[1]); w.w = pkh(b[2], b[3]); return w; }
__device__ __forceinline__ v2u pack4(const accv& a) { v2u w; w.x = pkh(a[0], a[1]); w.y = pkh(a[2], a[3]); return w; }
#define UP(base, bytes) ((GAS unsigned char*)(base) + (size_t)(bytes))
struct EpiProj {
    static constexpr bool PERM = true, AFTER_DRAIN = false;
    unsigned char* ws; const float* kvg; LAS float* xs;
    __device__ __forceinline__ void store8(GAS unsigned char* dst, int ld, int colbase, const accv (&acc)[2][2][4][2], int pm, unsigned lrow, int wc, int fq, bool sig) const {
        const unsigned lo = (lrow * (unsigned)ld + (unsigned)(wc * 32 + 8 * fq)) * 2u;
#pragma unroll
        for (int ai = 0; ai < 2; ++ai)
#pragma unroll
            for (int m = 0; m < 4; ++m)
#pragma unroll
                for (int bj = 0; bj < 2; ++bj) {
                    accv a = acc[ai][bj][m][0], b = acc[ai][bj][m][1];
                    if (sig) { for (int e = 0; e < 4; ++e) { a[e] = sigm_f(a[e]); b[e] = sigm_f(b[e]); } }
                    *(GAS v4u*)(UP(dst, ((size_t)(pm * 256 + ai * 128 + m * 16) * ld + colbase + bj * 128) * 2) + lo) = pack8(a, b);
                    __builtin_amdgcn_sched_barrier(0);
                }
    }
    __device__ __forceinline__ void operator()(const accv (&acc)[2][2][4][2], const Unit& u, int wr, int wc, int fr_, int fq_) const {
        int fr = fr_, fq = fq_; asm volatile("" : "+v"(fr), "+v"(fq));
        unsigned char* ws_ = this->ws; asm volatile("" : "+s"(ws_)); GAS unsigned char* const ws = (GAS unsigned char*)ws_;
        const int pn = u.pn, pm = u.pm; const unsigned lrow = (unsigned)(wr * 64 + fr);
        if (pn < 4 || pn == 12 || pn == 13) {
            const bool isv = pn >= 12; store8(isv ? ws + WS_VB : ws + WS_QLAT, isv ? 512 : DM, (isv ? pn - 12 : pn) * 256, acc, pm, lrow, wc, fq, false); return; }
        if (pn >= 14) { const bool isb = pn >= 18; store8(isb ? ws + WS_GB : ws + WS_GA, DM, ((pn - 14) & 3) * 256, acc, pm, lrow, wc, fq, true); return; }
        const unsigned jq = (pn == 5) ? (unsigned)(fq & 1) : (unsigned)(fq & 1) + 0u * 0u;
        const unsigned lo_rope = (lrow * 16u + 4u * ((pn == 5) ? jq : (unsigned)fq)) * 4u;
        GAS unsigned char* const ROPE = ws + WS_ROPE;
#define ROPE_CS(ai, m, c, s) const accv c = *(const GAS accv*)(UP(ROPE, (size_t)(pm * 256 + (ai) * 128 + (m) * 16) * 64) + lo_rope), s = *(const GAS accv*)(UP(ROPE, (size_t)(pm * 256 + (ai) * 128 + (m) * 16) * 64 + 32) + lo_rope)
        if (pn == 4) {
#pragma unroll
            for (int ai = 0; ai < 2; ++ai)
#pragma unroll
                for (int m = 0; m < 4; ++m) { const accv a = acc[ai][0][m][0], b = acc[ai][0][m][1];
                    float s = (a[0] * a[0] + a[1] * a[1]) + (a[2] * a[2] + a[3] * a[3]) + (b[0] * b[0] + b[1] * b[1]) + (b[2] * b[2] + b[3] * b[3]);
                    s += __shfl_xor(s, 16); s += __shfl_xor(s, 32);
                    if (fq == 0) xs[(ai * 128 + m * 16 + (int)lrow) * 4 + wc] = s; }
            asm volatile("s_waitcnt lgkmcnt(0)" ::: "memory"); __builtin_amdgcn_s_barrier(); asm volatile("" ::: "memory");
            GAS unsigned char* const CK = ws + WS_CKVR; GAS unsigned char* const KI = ws + WS_KIDX; GAS unsigned char* const WI = ws + WS_WIDX;
            const accv g0 = *(const accv*)(kvg + wc * 32 + 8 * fq), g1 = *(const accv*)(kvg + wc * 32 + 8 * fq + 4);
            const unsigned lo_ck = (lrow * 160u + (unsigned)(wc * 32 + 8 * fq)) * 2u, lo_ki = (lrow * 64u) * 2u, lo_ckr = (lrow * 160u) * 2u, lo_wi = lrow * 32u;
#pragma unroll
            for (int ai = 0; ai < 2; ++ai)
#pragma unroll
                for (int m = 0; m < 4; ++m) { const int rl = ai * 128 + m * 16; const size_t rg = (size_t)(pm * 256 + rl);
                    const f32x4 p = *(const LAS f32x4*)(xs + (rl + (int)lrow) * 4);
                    const float rstd = 1.0f / sqrtf(((p[0] + p[1]) + (p[2] + p[3])) * (1.0f / 128.0f) + EPS_F);
                    *(GAS v4u*)(UP(CK, rg * 320) + lo_ck) = pack8(acc[ai][0][m][0] * rstd * g0, acc[ai][0][m][1] * rstd * g1);
                    const accv a = acc[ai][1][m][0], b = acc[ai][1][m][1];
                    if (wc == 0) {
                        if (fq < 2) { ROPE_CS(ai, m, c, s);
                            *(GAS v2u*)(UP(KI, rg * 128) + lo_ki + 8u * fq) = pack4(a * c - b * s); *(GAS v2u*)(UP(KI, rg * 128 + 16) + lo_ki + 8u * fq) = pack4(b * c + a * s); }
                        else *(GAS v4u*)(UP(KI, rg * 128) + lo_ki + 16u * fq) = pack8(a, b);
                    } else if (wc == 1) { *(GAS v4u*)(UP(KI, rg * 128 + 64) + lo_ki + 16u * fq) = pack8(a, b);
                    } else if (wc == 2) {
                        if (fq < 2) { ROPE_CS(ai, m, c, s);
                            *(GAS v2u*)(UP(CK, rg * 320 + 256) + lo_ckr + 8u * fq) = pack4(a * c - b * s); *(GAS v2u*)(UP(CK, rg * 320 + 272) + lo_ckr + 8u * fq) = pack4(b * c + a * s); }
                        else if (fq == 2) { *(GAS accv*)(UP(WI, rg * 32) + lo_wi) = a * 0.044194173824159216f; *(GAS accv*)(UP(WI, rg * 32 + 16) + lo_wi) = b * 0.044194173824159216f; }
                        else { const v4u z = {0u, 0u, 0u, 0u}; *(GAS v4u*)(UP(CK, rg * 320 + 288) + lo_ckr) = z; *(GAS v4u*)(UP(CK, rg * 320 + 304) + lo_ckr) = z; }
                    }
                    asm volatile("" ::: "memory"); __builtin_amdgcn_sched_barrier(0);
                }
            return;
        }
        if (pn == 5) {
            GAS unsigned char* const QR = ws + WS_QR; const unsigned lo_qr = (lrow * 128u + (unsigned)((2 * wc + (fq >> 1)) * 16) + 4u * jq) * 2u;
#pragma unroll
            for (int ai = 0; ai < 2; ++ai)
#pragma unroll
                for (int m = 0; m < 4; ++m) { const size_t rg = (size_t)(pm * 256 + ai * 128 + m * 16); const accv a = acc[ai][0][m][0], b = acc[ai][0][m][1];
                    ROPE_CS(ai, m, c, s);
                    *(GAS v2u*)(UP(QR, rg * 256) + lo_qr) = pack4(a * c - b * s); *(GAS v2u*)(UP(QR, rg * 256 + 16) + lo_qr) = pack4(b * c + a * s); asm volatile("" ::: "memory"); }
            return;
        }
        {
            GAS unsigned char* const dst = ws + ((pn < 8) ? WS_QIDX : (pn < 10) ? WS_QB : WS_KB); const bool isk = pn >= 10;
            float* const KM = (float*)(ws_ + WS_KMEAN) + (size_t)pm * 512;
            const unsigned lo_d = (lrow * 512u + (unsigned)((wc >> 1) * 64)) * 2u;
#pragma unroll
            for (int bj = 0; bj < 2; ++bj) {
                const int hb = 4 * (pn & 1) + 2 * bj;
                accv csum0 = {0.f, 0.f, 0.f, 0.f}, csum1 = {0.f, 0.f, 0.f, 0.f};
#pragma unroll
                for (int ai = 0; ai < 2; ++ai)
#pragma unroll
                    for (int m = 0; m < 4; ++m) { const size_t rg = (size_t)(pm * 256 + ai * 128 + m * 16); accv a = acc[ai][bj][m][0], b = acc[ai][bj][m][1];
                        GAS unsigned char* const rb = UP(dst, (rg * 512 + hb * 64) * 2);
                        if ((wc & 1) == 0) {
                            if (fq < 2) { ROPE_CS(ai, m, c, s);
                                const accv ra = a * c - b * s, rbv = b * c + a * s; a = ra; b = rbv;
                                *(GAS v2u*)(rb + lo_d + 8u * fq) = pack4(a); *(GAS v2u*)(rb + 16 + lo_d + 8u * fq) = pack4(b); }
                            else *(GAS v4u*)(rb + lo_d + 16u * fq) = pack8(a, b);
                        } else *(GAS v4u*)(rb + 64 + lo_d + 16u * fq) = pack8(a, b);
                        csum0 += a; csum1 += b; asm volatile("" ::: "memory"); __builtin_amdgcn_sched_barrier(0); }
                if (isk) {
#pragma unroll
                    for (int e = 0; e < 4; ++e) {
#pragma unroll
                        for (int o = 1; o < 16; o <<= 1) { csum0[e] += __shfl_xor(csum0[e], o); csum1[e] += __shfl_xor(csum1[e], o); } }
                    if (fr == 0) {
                        int ch0, ch1;
                        if ((wc & 1) == 0) { if (fq < 2) { ch0 = 4 * fq; ch1 = 8 + 4 * fq; } else { ch0 = 8 * fq; ch1 = 8 * fq + 4; } } else { ch0 = 32 + 8 * fq; ch1 = 36 + 8 * fq; }
                        float* kb_ = KM + (hb + (wc >> 1)) * 64;
#pragma unroll
                        for (int e = 0; e < 4; ++e) { atomicAdd(kb_ + ch0 + e, csum0[e]); atomicAdd(kb_ + ch1 + e, csum1[e]); }
                    }
                }
            }
        }
#undef ROPE_CS
    }
};
template <bool ADD>
struct EpiBranch {
    static constexpr bool PERM = true, AFTER_DRAIN = false;
    const h16* G; h16* Y;
    __device__ __forceinline__ void operator()(const accv (&acc)[2][2][4][2], const Unit& u, int wr, int wc, int fr, int fq) const {
        const int row0 = u.pm * 256 + wr * 64 + fr;
#pragma unroll
        for (int ai = 0; ai < 2; ++ai)
#pragma unroll
            for (int m = 0; m < 4; ++m)
#pragma unroll
                for (int bj = 0; bj < 2; ++bj) {
                    const size_t off = (size_t)(row0 + ai * 128 + m * 16) * DM + u.pn * 256 + bj * 128 + wc * 32 + 8 * fq;
                    const f16x8 g = __builtin_bit_cast(f16x8, *(const v4u*)(G + off));
                    accv a = acc[ai][bj][m][0], b = acc[ai][bj][m][1];
#pragma unroll
                    for (int e = 0; e < 4; ++e) { a[e] *= (float)g[e]; b[e] *= (float)g[4 + e]; }
                    if (ADD) { const f16x8 y = __builtin_bit_cast(f16x8, *(const v4u*)(Y + off));
#pragma unroll
                        for (int e = 0; e < 4; ++e) { a[e] += (float)y[e]; b[e] += (float)y[4 + e]; } }
                    *(v4u*)(Y + off) = pack8(a, b);
                }
    }
};
namespace moba_body {
using bf16=unsigned short;
using bf16x8=__attribute__((ext_vector_type(8)))_Float16;
using s16x8=__attribute__((ext_vector_type(8)))short;
using s16x4=__attribute__((ext_vector_type(4)))short;
using f32x16=__attribute__((ext_vector_type(16)))float;
using u32x4=__attribute__((ext_vector_type(4)))unsigned;
constexpr int BATCH=2,NHEAD=8,SEQ=8192,D=64,DM=NHEAD*D;
constexpr int NW=8,QBLK=32,QB=QBLK*NW,KVBLK=64,NQB=SEQ/QB;
constexpr int ATTN_PITCH=DM, ATTN_UNIT_ROWS=QB;
__device__ __forceinline__ int crow(int r,int hi){return (r&3)+8*(r>>2)+4*hi;}
#define SBAR() __builtin_amdgcn_sched_barrier(0)
__device__ __forceinline__ void cmask(f32x16&p0,f32x16&p1,int jb,int qrel,int hi){
  const float NEG=-INFINITY; int kb=64*jb+4*hi;
  #pragma unroll
  for(int r=0;r<16;++r){int kv=kb+(r&3)+8*(r>>2); if(kv>qrel)p0[r]=NEG; if(kv+32>qrel)p1[r]=NEG;}
}

constexpr float NEGS=-1000.0f;
__device__ __forceinline__ void selm(f32x16&p0,f32x16&p1,unsigned selmask,int t){
  const bool keep=((selmask>>(t>>2))&1u)!=0u;
  #pragma unroll
  for(int r=0;r<16;++r){p0[r]=keep?p0[r]:NEGS;p1[r]=keep?p1[r]:NEGS;}
}
constexpr int NSLOT=3, SLOTB=8192;
constexpr int LDS_K=0, LDS_V=NSLOT*SLOTB, LDS_WS=2*NSLOT*SLOTB, LDS_OST=LDS_WS+NW*64*4, LDS_BYTES=LDS_OST+NW*4096;
constexpr float C2=0.125f*1.4426950408889634f;
__device__ __forceinline__ void glds16(const void*gsrc,unsigned lds_dst){unsigned keep;
  asm volatile("s_mov_b32 %0, m0\n\ts_mov_b32 m0, %2\n\ts_nop 0\n\tglobal_load_lds_dwordx4 %1, off\n\ts_mov_b32 m0, %0":"=&s"(keep):"v"(gsrc),"s"(lds_dst):"memory");}
__device__ __forceinline__ float max3f(float a,float b,float c){float r;asm("v_max3_f32 %0, %1, %2, %3":"=v"(r):"v"(a),"v"(b),"v"(c));return r;}
__device__ __forceinline__ float max2f(float a,float b){float r;asm("v_max_f32_e32 %0, %1, %2":"=v"(r):"v"(a),"v"(b));return r;}
__device__ __forceinline__ float fadd_s(float a,float b){float r;asm("v_add_f32_e32 %0, %1, %2":"=v"(r):"v"(a),"v"(b));return r;}
__device__ __forceinline__ float fsub_s(float a,float b){float r;asm("v_sub_f32_e32 %0, %1, %2":"=v"(r):"v"(a),"v"(b));return r;}
typedef float f32x2_t __attribute__((ext_vector_type(2))); typedef _Float16 bf16x2_t __attribute__((ext_vector_type(2)));
__device__ __forceinline__ unsigned cvtpk_s(float lo,float hi){f32x2_t v={lo,hi};bf16x2_t b=__builtin_convertvector(v,bf16x2_t);return __builtin_bit_cast(unsigned,b);}
#define WAIT_BAR(N) asm volatile("s_waitcnt vmcnt(" #N ") lgkmcnt(0)\n\ts_barrier":::"memory")

__device__ __forceinline__ void qkt(f32x16&p0,f32x16&p1,const char*Kslot,const bf16x8*qr,const f32x16&negm,int r32,int hi){
  const char*kb=Kslot+hi*1024+r32*16;
  #pragma unroll
  for(int d0=0;d0<4;++d0){
    const bf16x8 b0=*reinterpret_cast<const bf16x8*>(kb+d0*2048);
    const bf16x8 b1=*reinterpret_cast<const bf16x8*>(kb+d0*2048+512);
    if(d0==0){p0=__builtin_amdgcn_mfma_f32_32x32x16_f16(b0,qr[0],negm,0,0,0);p1=__builtin_amdgcn_mfma_f32_32x32x16_f16(b1,qr[0],negm,0,0,0);}
    else{p0=__builtin_amdgcn_mfma_f32_32x32x16_f16(b0,qr[d0],p0,0,0,0);p1=__builtin_amdgcn_mfma_f32_32x32x16_f16(b1,qr[d0],p1,0,0,0);}}
}
typedef __attribute__((address_space(3))) const char* lds_cptr;
typedef short v4i16_t __attribute__((ext_vector_type(4)));
__device__ __forceinline__ void kload8(bf16x8*kf,lds_cptr kp){
  kf[0]=*(const __attribute__((address_space(3))) bf16x8*)(kp);      kf[1]=*(const __attribute__((address_space(3))) bf16x8*)(kp+512);
  kf[2]=*(const __attribute__((address_space(3))) bf16x8*)(kp+2048); kf[3]=*(const __attribute__((address_space(3))) bf16x8*)(kp+2560);
  kf[4]=*(const __attribute__((address_space(3))) bf16x8*)(kp+4096); kf[5]=*(const __attribute__((address_space(3))) bf16x8*)(kp+4608);
  kf[6]=*(const __attribute__((address_space(3))) bf16x8*)(kp+6144); kf[7]=*(const __attribute__((address_space(3))) bf16x8*)(kp+6656);
}
__device__ __forceinline__ void kload2(bf16x8*kf,lds_cptr kp,int j){ kf[2*j]=*(const __attribute__((address_space(3))) bf16x8*)(kp+j*2048); kf[2*j+1]=*(const __attribute__((address_space(3))) bf16x8*)(kp+j*2048+512); }
__device__ __forceinline__ s16x4 vtr(lds_cptr p){ return __builtin_bit_cast(s16x4,__builtin_amdgcn_ds_read_tr16_b64_v4i16((__attribute__((address_space(3))) v4i16_t*)p)); }
__device__ __forceinline__ float rowmax(const f32x16&p0,const f32x16&p1){
  float a=max3f(p0[0],p0[1],p1[0]),b=max3f(p0[2],p0[3],p1[1]);a=max3f(a,p1[2],p1[3]);
  #pragma unroll
  for(int r=4;r<16;r+=4){a=max3f(a,p0[r],p0[r+1]);b=max3f(b,p0[r+2],p0[r+3]);a=max3f(a,p1[r],p1[r+1]);b=max3f(b,p1[r+2],p1[r+3]);}
  const float m=max2f(a,b);
  auto rr=__builtin_amdgcn_permlane32_swap(__float_as_uint(m),__float_as_uint(m),false,false);
  return max2f(__uint_as_float(rr[0]),__uint_as_float(rr[1]));
}
__device__ __forceinline__ void pv(f32x16*o,int vb,bf16x8 pa0,bf16x8 pa1,bf16x8 pa2,bf16x8 pa3){
  #pragma unroll
  for(int d0=0;d0<2;++d0){s16x4 lo[4],hi[4];
    #pragma unroll
    for(int ks=0;ks<4;++ks){
      asm volatile("ds_read_b64_tr_b16 %0,%1 offset:%c2":"=&v"(lo[ks]):"v"(vb),"i"(d0*4096+ks*1024):"memory");
      asm volatile("ds_read_b64_tr_b16 %0,%1 offset:%c2":"=&v"(hi[ks]):"v"(vb),"i"(d0*4096+ks*1024+512):"memory");}
    asm volatile("s_waitcnt lgkmcnt(0)":::"memory");SBAR();
    #define PK(k) __builtin_bit_cast(bf16x8,(s16x8){lo[k][0],lo[k][1],lo[k][2],lo[k][3],hi[k][0],hi[k][1],hi[k][2],hi[k][3]})
    o[d0]=__builtin_amdgcn_mfma_f32_32x32x16_f16(pa0,PK(0),o[d0],0,0,0);
    o[d0]=__builtin_amdgcn_mfma_f32_32x32x16_f16(pa1,PK(1),o[d0],0,0,0);
    o[d0]=__builtin_amdgcn_mfma_f32_32x32x16_f16(pa2,PK(2),o[d0],0,0,0);
    o[d0]=__builtin_amdgcn_mfma_f32_32x32x16_f16(pa3,PK(3),o[d0],0,0,0);
    #undef PK
  }
}

#ifndef ATTN_STORE16
#define ATTN_STORE16(p,v) (*(u32x4*)(p)=(v))
#endif
template<int THRL> __device__ __forceinline__ void attn_unit(int b,int h,int qb,const bf16*Q,const bf16*__restrict__ K,const bf16*__restrict__ V,bf16*O,const float*__restrict__ KMEAN,char*shm){
  const int tid=threadIdx.x,lane=tid&63,r32=lane&31,hi=lane>>5; const int wid=__builtin_amdgcn_readfirstlane(tid>>6);
  const long rowbase=(long)b*SEQ; const int q0=qb*QB;
  const bf16*Qw=Q+(rowbase+q0+wid*QBLK)*DM+h*D;
  unsigned selmask=0u;
  if(qb>0){
    float qf[64];
    { const u32x4*qp=reinterpret_cast<const u32x4*>(&Qw[(long)r32*DM]);
      #pragma unroll
      for(int c=0;c<8;++c){ const u32x4 w=qp[c]; const bf16x8 hv=__builtin_bit_cast(bf16x8,w);
        #pragma unroll
        for(int e=0;e<8;++e)qf[c*8+e]=(float)hv[e]; } }
    float v1=-INFINITY,v2=-INFINITY,v3=-INFINITY; int i1=-1,i2=-1,i3=-1;
    for(int j=0;j<qb;++j){
      const float*km=KMEAN+((long)(b*32+j)*DM+h*D);
      float g0=0.f,g1=0.f,g2=0.f,g3=0.f;
      #pragma unroll
      for(int d=0;d<64;d+=4){g0+=qf[d]*km[d];g1+=qf[d+1]*km[d+1];g2+=qf[d+2]*km[d+2];g3+=qf[d+3]*km[d+3];}
      const float g=(g0+g1)+(g2+g3);
      const bool c1=g>v1,c2=g>v2,c3=g>v3;
      v3=c2?v2:(c3?g:v3); i3=c2?i2:(c3?j:i3);
      v2=c1?v1:(c2?g:v2); i2=c1?i1:(c2?j:i2);
      v1=c1?g:v1; i1=c1?j:i1;
    }
    if(i1>=0)selmask|=1u<<i1; if(i2>=0)selmask|=1u<<i2; if(i3>=0)selmask|=1u<<i3;
  }
  const bf16*Kh=K+rowbase*DM+h*D,*Vh=V+rowbase*DM+h*D;
  const unsigned lds0=(unsigned)(uintptr_t)shm;
  float*wsf=(float*)(shm+LDS_WS)+wid*64;
  const bf16*ksrc=Kh+(long)lane*DM+wid*8;
  const bf16*vsrc=Vh+(long)(16*(wid&3)+(lane>>2))*DM+(wid>>2)*32+(lane&3)*8;
  const unsigned kdst=lds0+LDS_K+wid*1024, vdst=lds0+LDS_V+wid*1024;
  #define DMA_K(t,slot) glds16(ksrc+(long)(t)*KVBLK*DM,(unsigned)__builtin_amdgcn_readfirstlane(kdst+(slot)))
  #define DMA_V(t,slot) glds16(vsrc+(long)(t)*KVBLK*DM,(unsigned)__builtin_amdgcn_readfirstlane(vdst+(slot)))
  const int vb0=(int)(lds0+LDS_V)+((lane>>4)&1)*32+(lane&3)*8+(4*hi+((lane&15)>>2))*64;
  const char*Kbase=shm+LDS_K; bf16x8 kf[8];
  const lds_cptr shm3=(lds_cptr)shm; const lds_cptr kp0=shm3+LDS_K+hi*1024+r32*16; const lds_cptr vp0=shm3+LDS_V+((lane>>4)&1)*32+(lane&3)*8+(4*hi+((lane&15)>>2))*64;
  const int NT=(q0+QB)/KVBLK;
  DMA_K(0,0);DMA_V(0,0);DMA_K(1,SLOTB);
  bf16x8 qr[4];
  #pragma unroll
  for(int d0=0;d0<4;++d0)qr[d0]=*reinterpret_cast<const bf16x8*>(&Qw[(long)r32*DM+d0*16+hi*8]);
  float mhat=0.f,l_reg=0.f;f32x16 o[2];o[0]=f32x16{};o[1]=f32x16{};f32x16 negm=f32x16{};asm volatile("":"+v"(negm));
  const int qrel=wid*QBLK+r32;
  #define CMASK(P0,P1,t) do{int jb_=(t)-(NT-4); if(jb_>=0)cmask(P0,P1,jb_,qrel,hi); else selm(P0,P1,selmask,(t));}while(0)
  bool resc=false;
  #define START(P0,P1) do{ const float rm=rowmax(P0,P1); resc=false; \
    { const float dl=rm; mhat=fadd_s(mhat,dl); \
      _Pragma("unroll") for(int r=0;r<16;++r){P0[r]=fsub_s(P0[r],dl);P1[r]=fsub_s(P1[r],dl);} \
      _Pragma("unroll") for(int r=0;r<16;++r)negm[r]=-mhat; asm volatile("":"+v"(negm)); } \
    _Pragma("unroll") for(int r=0;r<16;++r)P0[r]=__builtin_amdgcn_exp2f(P0[r]); }while(0)
  #define RESC() do{ if(resc){ asm volatile("s_waitcnt lgkmcnt(0)":::"memory"); \
      _Pragma("unroll") for(int d_=0;d_<2;++d_) _Pragma("unroll") for(int r=0;r<16;++r)o[d_][r]*=wsf[crow(r,hi)]; } }while(0)
  f32x16 pA0,pA1,pB0,pB1;
  int sl_prev=0,sl_cur=0,sl_next=SLOTB;
  #define ROT() do{sl_prev=sl_cur;sl_cur=sl_next;sl_next=(sl_next==(NSLOT-1)*SLOTB)?0:sl_next+SLOTB;}while(0)
  DMA_K(2,2*SLOTB);
  WAIT_BAR(3);
  qkt(pA0,pA1,Kbase,qr,negm,r32,hi);asm volatile("s_nop 15\n\ts_nop 7":"+v"(pA0),"+v"(pA1));CMASK(pA0,pA1,0);
  START(pA0,pA1);
  _Pragma("unroll") for(int r=0;r<16;++r)pA1[r]=__builtin_amdgcn_exp2f(pA1[r]);
  WAIT_BAR(0);
  DMA_K(3,0);DMA_V(1,SLOTB);
  ROT();
  kload8(kf,kp0+sl_cur);
  WAIT_BAR(2);
  s16x4 vlo[8],vhi[8]; u32x4 pw0,pw1,pw2,pw3;
  #define PKW(P,B) cvtpk_s(P[B],P[B+1])
  #define PAF(k) __builtin_bit_cast(bf16x8,pw##k)
  #define VFR(i) __builtin_bit_cast(bf16x8,(s16x8){vlo[i][0],vlo[i][1],vlo[i][2],vlo[i][3],vhi[i][0],vhi[i][1],vhi[i][2],vhi[i][3]})
  #define PIN(x) asm volatile("":"+v"(x))
  #define MX3(a,b,c) __builtin_fmaxf(__builtin_fmaxf((a),(b)),(c))
  #define GAPA(MF,A0,A1,A2,A3,W0,W1,PW) do{ MF; sacc+=A0; sacc+=A1; sacc+=A2; sacc+=A3; PIN(sacc); W0; W1; PIN(PW); SBAR(); }while(0)
  #define EX(v) __builtin_amdgcn_exp2f(v)
  #define GAPB(MF,X,B) do{ MF; X[B]=EX(X[B]); X[B+1]=EX(X[B+1]); X[B+2]=EX(X[B+2]); X[B+3]=EX(X[B+3]); PIN(X); SBAR(); }while(0)
  #define VRD(i) do{ vlo[i]=vtr(vp_+(((i)>>2)*4096+((i)&3)*1024)); vhi[i]=vtr(vp_+(((i)>>2)*4096+((i)&3)*1024+512)); }while(0)
  #define KRD(G,j) do{ if(G){ kload2(kf,kp0+sl_next,j); SBAR(); } }while(0)
  #define STEP(C0,C1,P0,P1,t,GK,GV,GL) do{ SBAR(); \
    const lds_cptr vp_=vp0+sl_prev; \
    VRD(0); SBAR(); float sacc=(P0[0]+P0[1]); \
    GAPA(C0=__builtin_amdgcn_mfma_f32_32x32x16_f16(kf[0],qr[0],negm,0,0,0), P0[2],P0[3],P0[4],P0[5],     pw0[0]=PKW(P0,0), pw0[1]=PKW(P0,2), pw0); \
    VRD(4); SBAR(); GAPA(C1=__builtin_amdgcn_mfma_f32_32x32x16_f16(kf[1],qr[0],negm,0,0,0), P0[6],P0[7],P0[8],P0[9],     pw0[2]=PKW(P0,4), pw0[3]=PKW(P0,6), pw0); \
    VRD(1); SBAR(); GAPA(C0=__builtin_amdgcn_mfma_f32_32x32x16_f16(kf[2],qr[1],C0,0,0,0),   P0[10],P0[11],P0[12],P0[13], pw1[0]=PKW(P0,8), pw1[1]=PKW(P0,10), pw1); \
    VRD(5); SBAR(); GAPA(C1=__builtin_amdgcn_mfma_f32_32x32x16_f16(kf[3],qr[1],C1,0,0,0),   P0[14],P0[15],P1[0],P1[1],   pw1[2]=PKW(P0,12),pw1[3]=PKW(P0,14), pw1); \
    VRD(2); SBAR(); GAPA(C0=__builtin_amdgcn_mfma_f32_32x32x16_f16(kf[4],qr[2],C0,0,0,0),   P1[2],P1[3],P1[4],P1[5],     pw2[0]=PKW(P1,0), pw2[1]=PKW(P1,2), pw2); \
    VRD(6); SBAR(); GAPA(C1=__builtin_amdgcn_mfma_f32_32x32x16_f16(kf[5],qr[2],C1,0,0,0),   P1[6],P1[7],P1[8],P1[9],     pw2[2]=PKW(P1,4), pw2[3]=PKW(P1,6), pw2); \
    VRD(3); SBAR(); GAPA(C0=__builtin_amdgcn_mfma_f32_32x32x16_f16(kf[6],qr[3],C0,0,0,0),   P1[10],P1[11],P1[12],P1[13], pw3[0]=PKW(P1,8), pw3[1]=PKW(P1,10), pw3); \
    VRD(7); SBAR(); GAPA(C1=__builtin_amdgcn_mfma_f32_32x32x16_f16(kf[7],qr[3],C1,0,0,0),   P1[14],P1[15],0.f,0.f,       pw3[2]=PKW(P1,12),pw3[3]=PKW(P1,14), pw3); \
    l_reg+=sacc; \
    if(GK){DMA_K((t)+3,sl_cur);} if(GV){DMA_V((t)+1,sl_next);} \
    CMASK(C0,C1,t); \
    { float a=MX3(C0[0],C0[1],C1[0]),b=MX3(C0[2],C0[3],C1[1]); a=MX3(a,C1[2],C1[3]); \
      _Pragma("unroll") for(int r=4;r<16;r+=4){a=MX3(a,C0[r],C0[r+1]);b=MX3(b,C0[r+2],C0[r+3]);a=MX3(a,C1[r],C1[r+1]);b=MX3(b,C1[r+2],C1[r+3]);} \
      float rm=__builtin_fmaxf(a,b); { auto rr=__builtin_amdgcn_permlane32_swap(__float_as_uint(rm),__float_as_uint(rm),false,false); rm=__builtin_fmaxf(__uint_as_float(rr[0]),__uint_as_float(rr[1])); } \
      resc=false; \
      if(__builtin_expect(__any(rm>(float)THRL),0)){ const float dl=__builtin_fmaxf(rm,0.f); mhat+=dl; \
        _Pragma("unroll") for(int r=0;r<16;++r){C0[r]-=dl;C1[r]-=dl;} \
        _Pragma("unroll") for(int r=0;r<16;++r)negm[r]=-mhat; asm volatile("":"+v"(negm)); \
        const float f=__builtin_amdgcn_exp2f(-dl); l_reg*=f; if(hi==0)wsf[r32]=f; resc=true; } } \
    SBAR(); \
    GAPB(o[0]=__builtin_amdgcn_mfma_f32_32x32x16_f16(PAF(0),VFR(0),o[0],0,0,0), C0,0); \
    GAPB(o[1]=__builtin_amdgcn_mfma_f32_32x32x16_f16(PAF(0),VFR(4),o[1],0,0,0), C0,4); \
    KRD(GL,0); GAPB(o[0]=__builtin_amdgcn_mfma_f32_32x32x16_f16(PAF(1),VFR(1),o[0],0,0,0), C0,8); \
    KRD(GL,1); GAPB(o[1]=__builtin_amdgcn_mfma_f32_32x32x16_f16(PAF(1),VFR(5),o[1],0,0,0), C0,12); \
    KRD(GL,2); GAPB(o[0]=__builtin_amdgcn_mfma_f32_32x32x16_f16(PAF(2),VFR(2),o[0],0,0,0), C1,0); \
    KRD(GL,3); GAPB(o[1]=__builtin_amdgcn_mfma_f32_32x32x16_f16(PAF(2),VFR(6),o[1],0,0,0), C1,4); \
    GAPB(o[0]=__builtin_amdgcn_mfma_f32_32x32x16_f16(PAF(3),VFR(3),o[0],0,0,0), C1,8); \
    GAPB(o[1]=__builtin_amdgcn_mfma_f32_32x32x16_f16(PAF(3),VFR(7),o[1],0,0,0), C1,12); \
    }while(0)
  int t=1;
  #undef CMASK
  #define CMASK(P0,P1,t) selm(P0,P1,selmask,(t))
  for(;t+5<NT;t+=2){
    STEP(pB0,pB1,pA0,pA1,t,true,true,true);     WAIT_BAR(2); RESC(); ROT();
    STEP(pA0,pA1,pB0,pB1,t+1,true,true,true);   WAIT_BAR(2); RESC(); ROT();
  }
  #undef CMASK
  #define CMASK(P0,P1,t) do{int jb_=(t)-(NT-4); if(jb_>=0)cmask(P0,P1,jb_,qrel,hi); else selm(P0,P1,selmask,(t));}while(0)
  #define ENDW(tt) do{ if((tt)+3<NT){WAIT_BAR(2);} else if((tt)+2<NT){WAIT_BAR(1);} else {WAIT_BAR(0);} }while(0)
  for(;t+1<NT;t+=2){
    STEP(pB0,pB1,pA0,pA1,t,(t+3<NT),(t+1<NT),(t+1<NT));       ENDW(t);   RESC(); ROT();
    STEP(pA0,pA1,pB0,pB1,t+1,(t+4<NT),(t+2<NT),(t+2<NT));     ENDW(t+1); RESC(); ROT();
  }
  STEP(pB0,pB1,pA0,pA1,NT-1,false,false,false); RESC();
  { float sacc=pB0[0]+pB0[1]; _Pragma("unroll") for(int r=2;r<16;++r)sacc+=pB0[r]; _Pragma("unroll") for(int r=0;r<16;++r)sacc+=pB1[r]; l_reg+=sacc;
    pw0=(u32x4){PKW(pB0,0),PKW(pB0,2),PKW(pB0,4),PKW(pB0,6)};pw1=(u32x4){PKW(pB0,8),PKW(pB0,10),PKW(pB0,12),PKW(pB0,14)};pw2=(u32x4){PKW(pB1,0),PKW(pB1,2),PKW(pB1,4),PKW(pB1,6)};pw3=(u32x4){PKW(pB1,8),PKW(pB1,10),PKW(pB1,12),PKW(pB1,14)};
    SBAR(); pv(o,vb0+sl_cur,PAF(0),PAF(1),PAF(2),PAF(3)); }
  #undef PKW
  #undef PAF
  #undef VFR
  #undef PIN
  #undef MX3
  #undef GAPA
  #undef GAPB
  #undef EX
  #undef VRD
  #undef KRD
  #undef STEP
  #undef ENDW
  {auto rr=__builtin_amdgcn_permlane32_swap(__float_as_uint(l_reg),__float_as_uint(l_reg),false,false);l_reg=__uint_as_float(rr[0])+__uint_as_float(rr[1]);}
  if(hi==0)wsf[32+r32]=l_reg;asm volatile("s_waitcnt lgkmcnt(0)":::"memory");
  float rli[16];
  #pragma unroll
  for(int r=0;r<16;++r)rli[r]=__builtin_amdgcn_rcpf(wsf[32+crow(r,hi)]);
  bf16*Ow=O+(rowbase+q0+wid*QBLK)*DM+h*D;
  { bf16*stg=(bf16*)(shm+LDS_OST)+wid*2048;
    #pragma unroll
    for(int r=0;r<16;++r){const int orow=crow(r,hi);
      #pragma unroll
      for(int d0=0;d0<2;++d0)stg[orow*64+d0*32+r32]=__builtin_bit_cast(unsigned short,(_Float16)(o[d0][r]*rli[r]));}
    asm volatile("s_waitcnt lgkmcnt(0)":::"memory");
    #pragma unroll
    for(int i=0;i<4;++i){const int row=i*8+(lane>>3),ch=lane&7; const u32x4 v=*(const u32x4*)(stg+row*64+ch*8); ATTN_STORE16(Ow+(long)row*DM+ch*8,v);} }
  asm volatile("s_waitcnt lgkmcnt(0)\n\ts_barrier":::"memory");
  #undef DMA_K
  #undef DMA_V
  #undef CMASK
  #undef START
  #undef RESC
  #undef ROT
}
constexpr int ATTN_LDS_BYTES=LDS_BYTES;
struct AttnTensors { const bf16* Q; const bf16* K; const bf16* V; bf16* O; const float* KMEAN; };
struct AttnUnit { int bh; int qb; };
struct StaticOrder {
  int vcu,G;
  __device__ __forceinline__ explicit StaticOrder(int grid,int block):vcu((grid%8==0)?(block%8)*(grid/8)+block/8:block),G(grid){}
  __device__ __forceinline__ bool next(int i,AttnUnit&u)const{
    if(G==256){ if(i>=2)return false; const int s=vcu&15; u.bh=vcu>>4; u.qb=(i==0)?s:31-s; return true; }
    const int idx=i*G+vcu; if(idx>=512)return false; u.bh=idx>>5; u.qb=31-(idx&31); return true; }
  __device__ __forceinline__ void a_ready(const AttnUnit&)const{}
  __device__ __forceinline__ void done(const AttnUnit&)const{}
};
template<class Sched,int THRL=8> __device__ __forceinline__ void attn_phase(char*lds,const AttnTensors&T,const Sched&S){
  AttnUnit u;
  for(int i=0;S.next(i,u);++i){ S.a_ready(u); attn_unit<THRL>(u.bh/NHEAD,u.bh%NHEAD,u.qb,T.Q,T.K,T.V,T.O,T.KMEAN,lds); S.done(u); }
}
#undef SBAR
#undef WAIT_BAR
}
struct Frame {
    LAS unsigned char* lds;
    volatile LAS unsigned* MISC;
    gu32* ctl;
    int tid, lane, wave, vcu, G;
};
struct Args { const void* in[20]; float* out; unsigned char* ws; int ph_lo, ph_hi; };

__device__ __forceinline__ float wave_sum(float v) {
#pragma unroll
    for (int o = 1; o < 64; o <<= 1) v += __shfl_xor(v, o);
    return v;
}

__device__ __forceinline__ int ropemap32(int p) { return (p < 16) ? (((p >> 2) & 1) * 8 + (p >> 3) * 4 + (p & 3)) : p; }
__device__ __forceinline__ int win_src(int r, float& scale) {
    scale = 1.0f;
    const int tile = r >> 8, w = r & 255;
    if (tile == 4) {
        if (w < 128) return 512 + w;
        if (w < 192) return 1168 + ropemap32(w - 128);
        if (w < 224) { const int p = w - 192; if (p < 16) return 640 + ropemap32(p); if (p < 24) return 1232 + (p - 16); return -1; }
        return -1;
    }
    if (tile == 5) {
        if (w >= 128) return -1;
        const int grp = w >> 5, p = w & 31, fq = p >> 3, n = (p >> 2) & 1, e = p & 3;
        scale = C2F; return (2 * grp + (fq >> 1)) * 64 + n * 8 + 4 * (fq & 1) + e;
    }
    if (tile < 12) {
        const int base = (tile < 8) ? 656 : (tile < 10) ? 1240 : 1752, t0 = (tile < 8) ? 6 : (tile < 10) ? 8 : 10;
        const int rr = r - t0 * 256, hd = rr >> 6, g = rr & 63;
        if (tile == 8 || tile == 9) scale = C2F;
        return base + hd * 64 + ((g < 32) ? ropemap32(g) : g);
    }
    if (tile < 14) return 2264 + (r - 12 * 256);
    if (tile < 18) return 2776 + (r - 14 * 256);
    return 3800 + (r - 18 * 256);
}
template <int MODE>
__device__ __forceinline__ void wt_item(const float* W, int Nsrc, int K, h16* WT, int row_base, LAS float* scr, int kb, int nb, int lane, const float* aux) {
    const int k0 = 64 * kb, r = row_base + nb * 32 + (lane & 31), half = lane >> 5;
    if constexpr (MODE <= 2) {
        int sc_ = r; float scale = 1.0f;
        if (MODE == 1) { const int t = r >> 8, w = r & 255; sc_ = (w < 128) ? (128 * t + w) : (DFF + 128 * t + (w - 128)); }
        if (MODE == 2) sc_ = win_src(r, scale);
#pragma unroll 8
        for (int i = 0; i < 32; ++i) { const int kk = 2 * i + half; scr[kk * 33 + (lane & 31)] = (sc_ >= 0) ? W[(size_t)(k0 + kk) * Nsrc + sc_] * scale : 0.0f; }
    } else if constexpr (MODE == 3) {
        const int h = r >> 7, rr = r & 127; const float* uk = aux + rr * 384 + h * 48;
        float ukv[48];
#pragma unroll
        for (int n = 0; n < 48; ++n) ukv[n] = uk[n];
        for (int i = 0; i < 32; ++i) { const int kk = 2 * i + half; const float* wr_ = W + (size_t)(k0 + kk) * Nsrc + h * 64 + 16; float s = 0.f;
#pragma unroll
            for (int n = 0; n < 48; ++n) s += wr_[n] * ukv[n];
            scr[kk * 33 + (lane & 31)] = s * C2F; }
    } else {
        const int h = k0 >> 7; float bv[64];
#pragma unroll
        for (int d = 0; d < 64; ++d) bv[d] = W[(size_t)(h * 64 + d) * Nsrc + r];
        for (int i = 0; i < 32; ++i) { const int kk = 2 * i + half, rr = (k0 & 127) + kk; const float* uv = aux + rr * 512 + h * 64; float s = 0.f;
#pragma unroll
            for (int d = 0; d < 64; ++d) s += uv[d] * bv[d];
            scr[kk * 33 + (lane & 31)] = s; }
    }
    LDS_WAIT(); asm volatile("" ::: "memory");
    const int c = lane & 7;
#pragma unroll
    for (int j = 0; j < 4; ++j) { const int n = (lane >> 3) + 8 * j; const LAS float* s = scr + (8 * c) * 33 + n;
        v4u o; o.x = pkh(s[0 * 33], s[1 * 33]); o.y = pkh(s[2 * 33], s[3 * 33]); o.z = pkh(s[4 * 33], s[5 * 33]); o.w = pkh(s[6 * 33], s[7 * 33]);
        *(GAS v4u*)(WT + (size_t)(row_base + nb * 32 + n) * K + k0 + 8 * c) = o; }
    LDS_WAIT(); asm volatile("" ::: "memory");
}

__device__ __forceinline__ void rope_entry(int pos, int j, float& c, float& s) {
    const double invf[8] = {1.0, 0.19392274474868576, 0.03760603093086393, 0.007292664737217109, 0.001414213562373095, 0.0002742481756762073, 5.318295896944988e-05, 1.031338537721246e-05};
    double f = 1.0;
#pragma unroll
    for (int q = 0; q < 8; ++q) f = (q == j) ? invf[q] : f;
    const double ang = (double)pos * f;
    const double qd = __builtin_rint(ang * 0.6366197723675814);
    double r = __builtin_fma(-qd, 1.5707963267948966, ang); r = __builtin_fma(-qd, 6.123233995736766e-17, r);
    const double r2 = r * r;
    double sp = 1.0 / 6227020800.0; sp = sp * r2 - 1.0 / 39916800.0; sp = sp * r2 + 1.0 / 362880.0; sp = sp * r2 - 1.0 / 5040.0; sp = sp * r2 + 1.0 / 120.0; sp = sp * r2 - 1.0 / 6.0; sp = sp * r2 + 1.0;
    const double sn = r * sp;
    double cp = -1.0 / 87178291200.0; cp = cp * r2 + 1.0 / 479001600.0; cp = cp * r2 - 1.0 / 3628800.0; cp = cp * r2 + 1.0 / 40320.0; cp = cp * r2 - 1.0 / 720.0; cp = cp * r2 + 1.0 / 24.0; cp = cp * r2 - 0.5; cp = cp * r2 + 1.0;
    const int qi = ((int)qd) & 3;
    const double cc = (qi == 0) ? cp : (qi == 1) ? -sn : (qi == 2) ? -cp : sn;
    const double ss = (qi == 0) ? sn : (qi == 1) ? cp : (qi == 2) ? -sn : -cp;
    c = (float)cc; s = (float)ss;
}

__device__ __forceinline__ void p0_prologue(Frame& F, const Args& args) {
    unsigned char* ws = args.ws;
    const float* ada_w = (const float*)args.in[3]; const float* ada_b = (const float*)args.in[4]; const float* cvec = (const float*)args.in[1];
    {
        LAS float* red = (LAS float*)(F.lds + XS_OFF);
        float* MOD = (float*)(ws + WS_MOD);
        for (int it = F.vcu; it < NMODV / 64; it += F.G) {
            const int n = it * 64 + F.lane; float a0 = 0.f, a1 = 0.f;
            const int kbeg = F.wave * 128;
#pragma unroll 8
            for (int k = kbeg; k < kbeg + 128; ++k) { const float w = ada_w[(size_t)k * NMODV + n]; a0 += silu_f(cvec[k]) * w; a1 += silu_f(cvec[DM + k]) * w; }
            red[(F.wave * 2 + 0) * 64 + F.lane] = a0; red[(F.wave * 2 + 1) * 64 + F.lane] = a1;
            __syncthreads();
            if (F.wave < 2) { float s = ada_b[n];
#pragma unroll
                for (int w = 0; w < 8; ++w) s += red[(w * 2 + F.wave) * 64 + F.lane];
                MOD[(size_t)F.wave * NMODV + n] = s; }
            __syncthreads();
        }
    }
    {
        const int* pos = (const int*)args.in[2]; float* ROPE = (float*)(ws + WS_ROPE);
        for (int e = F.vcu * 512 + F.tid; e < MTOK * 8; e += F.G * 512) { const int m = e >> 3, j = e & 7; float c, s; rope_entry(pos[m], j, c, s); ROPE[(size_t)m * 16 + j] = c; ROPE[(size_t)m * 16 + 8 + j] = s; }
    }
    LAS float* scr = (LAS float*)(F.lds + RING_OFF + F.wave * 16384);
    const int gw = F.vcu * NWAVES + F.wave, NGW = F.G * NWAVES;
    const float* w1i = (const float*)args.in[6]; const float* w1o = (const float*)args.in[7]; const float* w2i = (const float*)args.in[17]; const float* w2o = (const float*)args.in[18];
    const float* win = (const float*)args.in[9]; const float* wuk = (const float*)args.in[11]; const float* wuv = (const float*)args.in[12];
    const float* wba = (const float*)args.in[13]; const float* wbb = (const float*)args.in[14]; const float* wo = (const float*)args.in[15];
    constexpr int I_QL = 16 * 32, I_BA = 16 * 32, I_1A = 16 * 176, I_1B = 44 * 32, I_IN = 16 * 144, I_BB = 8 * 32, I_O = 16 * 32;
    constexpr int NITEMS = I_QL + I_BA + 2 * I_1A + 2 * I_1B + I_IN + I_BB + I_O;
    for (int it = gw; it < NITEMS; it += NGW) {
        int r = it;
        if (r < I_QL) { wt_item<3>(win, 4824, DM, (h16*)(ws + WS_WIN), 0, scr, r / 32, r % 32, F.lane, wuk); continue; } r -= I_QL;
        if (r < I_BA) { wt_item<4>(wba, DM, DM, (h16*)(ws + WS_WBA), 0, scr, r / 32, r % 32, F.lane, wuv); continue; } r -= I_BA;
        if (r < I_1A) { wt_item<1>(w1i, 2 * DFF, DM, (h16*)(ws + WS_W1A), 0, scr, r / 176, r % 176, F.lane, nullptr); continue; } r -= I_1A;
        if (r < I_1A) { wt_item<1>(w2i, 2 * DFF, DM, (h16*)(ws + WS_W2A), 0, scr, r / 176, r % 176, F.lane, nullptr); continue; } r -= I_1A;
        if (r < I_1B) { wt_item<0>(w1o, DM, DFF, (h16*)(ws + WS_W1B), 0, scr, r / 32, r % 32, F.lane, nullptr); continue; } r -= I_1B;
        if (r < I_1B) { wt_item<0>(w2o, DM, DFF, (h16*)(ws + WS_W2B), 0, scr, r / 32, r % 32, F.lane, nullptr); continue; } r -= I_1B;
        if (r < I_IN) { wt_item<2>(win, 4824, DM, (h16*)(ws + WS_WIN), 1024, scr, r / 144, r % 144, F.lane, nullptr); continue; } r -= I_IN;
        if (r < I_BB) { wt_item<0>(wbb, DM, 512, (h16*)(ws + WS_WBB), 0, scr, r / 32, r % 32, F.lane, nullptr); continue; } r -= I_BB;
        wt_item<0>(wo, DM, DM, (h16*)(ws + WS_WO), 0, scr, r / 32, r % 32, F.lane, nullptr);
    }
}

template <int MODE>
__device__ __forceinline__ void norm_rows(Frame& F, const float* src, const float* g, const float* sh, const float* sc, h16* dst16, float* dst32) {
    const int gw = F.vcu * NWAVES + F.wave, NGW = F.G * NWAVES;
    for (int m0 = gw * 8; m0 < MTOK; m0 += NGW * 8) {
        const int b = m0 / SEQ;
        f32x4 av[4], sv[4];
#pragma unroll
        for (int j = 0; j < 4; ++j) { const int c = 4 * F.lane + 256 * j; av[j] = *(const f32x4*)(g + c);
            if (MODE == 0) { av[j] = av[j] * (*(const f32x4*)(sc + (size_t)b * NMODV + c) + 1.0f); sv[j] = *(const f32x4*)(sh + (size_t)b * NMODV + c); } }
        for (int m = m0; m < m0 + 8; ++m) {
            const GAS f32x4* xr = (const GAS f32x4*)(src + (size_t)m * DM) + F.lane;
            f32x4 v[4]; float s = 0.f;
#pragma unroll
            for (int j = 0; j < 4; ++j) { v[j] = xr[64 * j]; s += (v[j].x * v[j].x + v[j].y * v[j].y) + (v[j].z * v[j].z + v[j].w * v[j].w); }
            const float rstd = 1.0f / sqrtf(wave_sum(s) * (1.0f / DM) + EPS_F);
            if (MODE == 0) {
                GAS v2u* o8 = (GAS v2u*)(dst16 + (size_t)m * DM) + F.lane;
#pragma unroll
                for (int j = 0; j < 4; ++j) { const f32x4 y = v[j] * rstd * av[j] + sv[j]; v2u w; w.x = pkh(y.x, y.y); w.y = pkh(y.z, y.w); o8[64 * j] = w; }
            } else {
                GAS f32x4* o = (GAS f32x4*)(dst32 + (size_t)m * DM) + F.lane;
#pragma unroll
                for (int j = 0; j < 4; ++j) o[64 * j] = v[j] * rstd * av[j];
            }
        }
    }
}
namespace dsa {
typedef _Float16 f16x8 __attribute__((ext_vector_type(8)));
typedef float f32x4 __attribute__((ext_vector_type(4)));
typedef short s16x4 __attribute__((ext_vector_type(4)));
typedef short s16x8 __attribute__((ext_vector_type(8)));
constexpr int CAP = 768, TRIG = 512, KEEP = 256, SLACK = 320;
constexpr int L_KEY = 0, L_IDX = 49152, L_GBUF = 0, ROWB = 336, GBUF_W = 32 * ROWB, L_CNT = 118784, L_SEL = 122880;
static_assert(8 * GBUF_W <= L_CNT && L_IDX + 16 * CAP * 2 <= L_CNT, "dsa lds map");
__device__ __forceinline__ unsigned ordkey(float f) { const unsigned u = __builtin_bit_cast(unsigned, f); return (u & 0x80000000u) ? ~u : (u | 0x80000000u); }

template <bool EXACT>
__device__ __forceinline__ void wave_select(LAS unsigned* keyp, LAS unsigned short* idxp, int n, LAS unsigned* cntp, LAS unsigned* thrp, LAS unsigned short* selp, LAS unsigned* selnp, int lane) {
    unsigned kh[12], kl[12];
#pragma unroll
    for (int i = 0; i < 12; ++i) { const int e = i * 64 + lane; const bool v = e < n; kh[i] = v ? keyp[e] : 0u; kl[i] = v ? (8191u - (unsigned)idxp[e]) : 0u; }
    unsigned Th = 0u, Tl = 0u;
    if (n > KEEP) {
        int cge = n;
        for (int bit = 31; bit >= 0; --bit) {
            const unsigned cand = Th | (1u << bit); int c = 0;
#pragma unroll
            for (int i = 0; i < 12; ++i) c += __popcll(__ballot(kh[i] >= cand));
            if (c >= KEEP) { Th = cand; cge = c; if (!EXACT && c <= SLACK) break; }
        }
        if (cge > (EXACT ? KEEP : SLACK)) {
            int gt = 0;
#pragma unroll
            for (int i = 0; i < 12; ++i) gt += __popcll(__ballot(kh[i] > Th));
            const int R = KEEP - gt;
            for (int bit = 12; bit >= 0; --bit) {
                const unsigned cand = Tl | (1u << bit); int c = 0;
#pragma unroll
                for (int i = 0; i < 12; ++i) c += __popcll(__ballot(kh[i] == Th && kl[i] >= cand));
                if (c >= R) Tl = cand;
            }
        }
    }
    int base = 0; const unsigned long long ltmask = (1ull << lane) - 1ull;
#pragma unroll
    for (int i = 0; i < 12; ++i) {
        const bool keep = (n > KEEP) ? (kh[i] > Th || (kh[i] == Th && kl[i] >= Tl)) : (i * 64 + lane < n);
        const unsigned long long m = __ballot(keep); const int pos = base + __popcll(m & ltmask);
        if (keep) { if (EXACT) selp[pos] = (unsigned short)(8191u - kl[i]); else { keyp[pos] = kh[i]; idxp[pos] = (unsigned short)(8191u - kl[i]); } }
        base += __popcll(m);
    }
    if (lane == 0) { if (EXACT) selnp[0] = (unsigned)base; else { cntp[0] = (unsigned)base; thrp[0] = Th; } }
}

__device__ __forceinline__ void dsa_unit(unsigned char* ws, LAS unsigned char* lds, int b, int qt, int tid) {
    const int lane = tid & 63, wave = __builtin_amdgcn_readfirstlane(tid >> 6), g = lane >> 4, c16 = lane & 15;
    const int t0 = 16 * qt; const size_t m0 = (size_t)b * SEQ + t0;
    LAS unsigned* KEYS = (LAS unsigned*)(lds + L_KEY); LAS unsigned short* IDXS = (LAS unsigned short*)(lds + L_IDX);
    LAS unsigned* CNT = (LAS unsigned*)(lds + L_CNT); LAS unsigned* THR = CNT + 16; LAS unsigned* SELN = CNT + 32;
    LAS unsigned short* SEL = (LAS unsigned short*)(lds + L_SEL);
    const GAS h16* QIDX = (const GAS h16*)(ws + WS_QIDX); const GAS h16* KIDX = (const GAS h16*)(ws + WS_KIDX); const GAS float* WIDX = (const GAS float*)(ws + WS_WIDX);
    if (tid < 16) { CNT[tid] = 0u; THR[tid] = 0u; }
    {
        f16x8 qf[8][2]; float wv[8];
#pragma unroll
        for (int h = 0; h < 8; ++h) {
#pragma unroll
            for (int ks = 0; ks < 2; ++ks) qf[h][ks] = *(const GAS f16x8*)(QIDX + (m0 + c16) * 512 + h * 64 + ks * 32 + 8 * g);
            wv[h] = WIDX[(m0 + c16) * 8 + h]; }
        const int nsteps = (t0 + 16 + 255) >> 8;
        const int tq = t0 + c16;
        for (int step = 0; step < nsteps; ++step) {
            const int kb0 = step * 256 + wave * 32;
            float sc[2][4];
#pragma unroll
            for (int kt = 0; kt < 2; ++kt) {
                const int kb = kb0 + 16 * kt;
                if (kb <= t0 + 15) {
                    const GAS h16* kr = KIDX + ((size_t)b * SEQ + kb + c16) * 64 + 8 * g;
                    const f16x8 a0 = *(const GAS f16x8*)kr, a1 = *(const GAS f16x8*)(kr + 32);
                    f32x4 s = {0.f, 0.f, 0.f, 0.f};
#pragma unroll
                    for (int h = 0; h < 8; ++h) {
                        f32x4 acc = {0.f, 0.f, 0.f, 0.f};
                        acc = __builtin_amdgcn_mfma_f32_16x16x32_f16(a0, qf[h][0], acc, 0, 0, 0);
                        acc = __builtin_amdgcn_mfma_f32_16x16x32_f16(a1, qf[h][1], acc, 0, 0, 0);
#pragma unroll
                        for (int r = 0; r < 4; ++r) s[r] += wv[h] * fmaxf(acc[r], 0.f);
                    }
#pragma unroll
                    for (int r = 0; r < 4; ++r) sc[kt][r] = s[r];
                } else {
#pragma unroll
                    for (int r = 0; r < 4; ++r) sc[kt][r] = 0.f;
                }
            }
            __syncthreads();
            const unsigned thr = THR[c16];
#pragma unroll
            for (int kt = 0; kt < 2; ++kt)
#pragma unroll
                for (int r = 0; r < 4; ++r) {
                    const int s = kb0 + 16 * kt + 4 * g + r; const unsigned key = ordkey(sc[kt][r]);
                    if (s <= tq && key > thr) { const unsigned pos = __hip_atomic_fetch_add(CNT + c16, 1u, __ATOMIC_RELAXED, __HIP_MEMORY_SCOPE_WORKGROUP);
                        if (pos < (unsigned)CAP) { KEYS[c16 * CAP + pos] = key; IDXS[c16 * CAP + pos] = (unsigned short)s; } }
                }
            __syncthreads();
            if (step + 1 < nsteps) {
                bool any = false;
#pragma unroll
                for (int q = 0; q < 16; ++q) any |= CNT[q] > (unsigned)TRIG;
                if (any) {
#pragma unroll
                    for (int qi = 0; qi < 2; ++qi) { const int q = 2 * wave + qi; const int n = (int)CNT[q];
                        if (n > 384) wave_select<false>(KEYS + q * CAP, IDXS + q * CAP, n, CNT + q, THR + q, nullptr, nullptr, lane); }
                }
            }
        }
    }
#pragma unroll
    for (int qi = 0; qi < 2; ++qi) { const int q = 2 * wave + qi; int n = (int)CNT[q]; n = n > CAP ? CAP : n;
        wave_select<true>(KEYS + q * CAP, IDXS + q * CAP, n, nullptr, nullptr, SEL + q * 256, SELN + q, lane); }
    __syncthreads();
    const GAS h16* QLAT = (const GAS h16*)(ws + WS_QLAT); const GAS h16* QR = (const GAS h16*)(ws + WS_QR); const GAS unsigned char* CK = (const GAS unsigned char*)(ws + WS_CKVR) + (size_t)b * SEQ * 320;
    LAS unsigned char* gb = lds + L_GBUF + wave * GBUF_W;
    for (int qi = 0; qi < 2; ++qi) {
        const int q = 2 * wave + qi; const size_t m = m0 + q; const int nsel = (int)SELN[q]; const int nch = (nsel + 31) >> 5;
        LAS unsigned short* selq = SEL + q * 256;
        f16x8 bq[5];
        { const f16x8 z = {0, 0, 0, 0, 0, 0, 0, 0};
#pragma unroll
          for (int ks = 0; ks < 4; ++ks) bq[ks] = (c16 < 8) ? *(const GAS f16x8*)(QLAT + m * 1024 + c16 * 128 + ks * 32 + 8 * g) : z;
          bq[4] = (c16 < 8 && g < 2) ? *(const GAS f16x8*)(QR + m * 128 + c16 * 16 + 8 * g) : z; }
        f32x4 O[8];
#pragma unroll
        for (int rt = 0; rt < 8; ++rt) O[rt] = (f32x4){0.f, 0.f, 0.f, 0.f};
        float mrun = -INFINITY, lrun = 0.f;
        v4u pre[10];
#pragma unroll
        for (int i = 0; i < 10; ++i) { const int id = i * 64 + lane, ksl = id / 20, part = id - ksl * 20; const int slot = ksl; const unsigned idx = (slot < nsel) ? (unsigned)selq[slot] : 0u;
            pre[i] = *(const GAS v4u*)(CK + (size_t)idx * 320 + part * 16); }
        for (int c = 0; c < nch; ++c) {
#pragma unroll
            for (int i = 0; i < 10; ++i) { const int id = i * 64 + lane, ksl = id / 20, part = id - ksl * 20; *(LAS v4u*)(gb + ksl * ROWB + part * 16) = pre[i]; }
            if (c + 1 < nch) {
#pragma unroll
                for (int i = 0; i < 10; ++i) { const int id = i * 64 + lane, ksl = id / 20, part = id - ksl * 20; const int slot = (c + 1) * 32 + ksl; const unsigned idx = (slot < nsel) ? (unsigned)selq[slot] : 0u;
                    pre[i] = *(const GAS v4u*)(CK + (size_t)idx * 320 + part * 16); }
            }
            f32x4 st[2];
#pragma unroll
            for (int kt = 0; kt < 2; ++kt) { f32x4 acc = {0.f, 0.f, 0.f, 0.f};
#pragma unroll
                for (int ks = 0; ks < 5; ++ks) { const f16x8 a = *(const LAS f16x8*)(gb + (kt * 16 + c16) * ROWB + ks * 64 + g * 16); acc = __builtin_amdgcn_mfma_f32_16x16x32_f16(a, bq[ks], acc, 0, 0, 0); }
                st[kt] = acc; }
            float cm = -INFINITY;
#pragma unroll
            for (int kt = 0; kt < 2; ++kt)
#pragma unroll
                for (int r = 0; r < 4; ++r) { const int slot = c * 32 + kt * 16 + 4 * g + r; if (slot >= nsel) st[kt][r] = -INFINITY; cm = fmaxf(cm, st[kt][r]); }
            cm = fmaxf(cm, __shfl_xor(cm, 16)); cm = fmaxf(cm, __shfl_xor(cm, 32));
            const float mnew = fmaxf(mrun, cm); const float alpha = __builtin_amdgcn_exp2f(mrun - mnew); mrun = mnew;
            float ps = 0.f; float p[2][4];
#pragma unroll
            for (int kt = 0; kt < 2; ++kt)
#pragma unroll
                for (int r = 0; r < 4; ++r) { p[kt][r] = __builtin_amdgcn_exp2f(st[kt][r] - mnew); ps += p[kt][r]; }
            lrun = lrun * alpha + ps;
            float ar[4];
#pragma unroll
            for (int r = 0; r < 4; ++r) ar[r] = __shfl(alpha, 4 * g + r);
#pragma unroll
            for (int rt = 0; rt < 8; ++rt)
#pragma unroll
                for (int r = 0; r < 4; ++r) O[rt][r] *= ar[r];
            v4u paw; paw.x = pkh(p[0][0], p[0][1]); paw.y = pkh(p[0][2], p[0][3]); paw.z = pkh(p[1][0], p[1][1]); paw.w = pkh(p[1][2], p[1][3]);
            const f16x8 pa = __builtin_bit_cast(f16x8, paw);
            LAS unsigned char* tb = gb + (4 * g + (c16 >> 2)) * ROWB + (c16 & 3) * 8;
#pragma unroll
            for (int rt = 0; rt < 8; ++rt) {
                const s16x4 lo = __builtin_bit_cast(s16x4, __builtin_amdgcn_ds_read_tr16_b64_v4i16((LAS s16x4*)(tb + rt * 32)));
                const s16x4 hi = __builtin_bit_cast(s16x4, __builtin_amdgcn_ds_read_tr16_b64_v4i16((LAS s16x4*)(tb + 16 * ROWB + rt * 32)));
                const f16x8 bv = __builtin_bit_cast(f16x8, (s16x8){lo[0], lo[1], lo[2], lo[3], hi[0], hi[1], hi[2], hi[3]});
                O[rt] = __builtin_amdgcn_mfma_f32_16x16x32_f16(pa, bv, O[rt], 0, 0, 0);
            }
        }
        lrun += __shfl_xor(lrun, 16); lrun += __shfl_xor(lrun, 32);
        const float inv = 1.0f / lrun; float ir[4];
#pragma unroll
        for (int r = 0; r < 4; ++r) ir[r] = __shfl(inv, 4 * g + r);
        LAS unsigned short* ob = (LAS unsigned short*)gb;
        if (g < 2) {
#pragma unroll
            for (int rt = 0; rt < 8; ++rt)
#pragma unroll
                for (int r = 0; r < 4; ++r) ob[(4 * g + r) * 128 + rt * 16 + c16] = __builtin_bit_cast(unsigned short, (_Float16)(O[rt][r] * ir[r]));
        }
        asm volatile("s_waitcnt lgkmcnt(0)" ::: "memory");
        GAS h16* OL = (GAS h16*)(ws + WS_QLAT) + m * 1024;
#pragma unroll
        for (int i = 0; i < 2; ++i) { const int e = i * 64 + lane; *(GAS v4u*)(OL + e * 8) = *(const LAS v4u*)(ob + e * 8); }
        asm volatile("s_waitcnt lgkmcnt(0)" ::: "memory");
    }
    __syncthreads();
}

__device__ __forceinline__ void dsa_phase(Frame& F, unsigned char* ws) {
    if (F.G == 256) {
        const int b = F.vcu >> 7, c = F.vcu & 127;
        for (int i = 0; i < 4; ++i) { const int qt = (i == 0) ? c : (i == 1) ? 255 - c : (i == 2) ? 256 + c : 511 - c; dsa_unit(ws, F.lds, b, qt, F.tid); }
    } else {
        for (int u = F.vcu; u < 1024; u += F.G) dsa_unit(ws, F.lds, u >> 9, 511 - (u & 511), F.tid);
    }
}
}
using dsa::dsa_phase;
#ifndef MK_MIXER
#define MK_MIXER 1
#endif
#ifndef MK_DSA
#define MK_DSA 1
#endif
__global__ void __launch_bounds__(NWAVES * 64, 2) mega_fwd(Args args) {
    extern __shared__ __attribute__((aligned(16))) unsigned char lds[];
    Frame F;
    F.lds = (LAS unsigned char*)lds;
    F.MISC = (volatile LAS unsigned*)(F.lds + MISC_OFF);
    F.tid = threadIdx.x; F.lane = F.tid & 63; F.wave = __builtin_amdgcn_readfirstlane(F.tid >> 6);
    F.G = gridDim.x; { const int bx = blockIdx.x; F.vcu = (F.G % 8 == 0) ? (bx % 8) * (F.G / 8) + bx / 8 : bx; }
    unsigned char* ws = args.ws;
    F.ctl = (gu32*)(ws + WS_CTL);
    for (int u = F.tid; u < 1024 / 4; u += NWAVES * 64) ((LAS unsigned*)(F.lds + LDSCTL_OFF))[u] = 0u;
    __syncthreads();
    XcdBarrier bar; bar.bar = (unsigned*)(F.ctl + CW_BAR); bar.x = 0; bar.st = nullptr;
    if (!MK_SPLIT) bar = xcd_barrier_post((unsigned*)(F.ctl + CW_BAR), F.MISC + 8);
#define GRID_BAR() do { if (MK_SPLIT) { if (F.tid == 0) __hip_atomic_store(F.ctl + CW_TMO, 0xBADBA0u, RLX_AGENT); } else { xcd_barrier(bar); } } while (0)
    const int lo = args.ph_lo, hi = args.ph_hi;
#define IN(k) (lo <= (k) && (k) < hi)
#define BOTH(k) (IN(k) && IN((k) + 1))
    const float* x = (const float*)args.in[0];
    float* out = args.out;
    const float* MOD = (const float*)(ws + WS_MOD);
    h16* XN = (h16*)(ws + WS_XN); h16* HB = (h16*)(ws + WS_H);
    const int bx = (int)blockIdx.x;

    if (IN(0)) { p0_prologue(F, args); if (BOTH(0)) GRID_BAR(); }
    if (IN(1)) { norm_rows<0>(F, x, (const float*)args.in[5], MOD + 0 * DM, MOD + 1 * DM, XN, nullptr); if (BOTH(1)) GRID_BAR(); }
    if (IN(2)) {
        pg8::Gemm g{XN, (const h16*)(ws + WS_W1A), MTOK, 2 * DFF, DM}; pg8::StaticOrder S; S.init(MTOK, 2 * DFF, F.G, bx);
        EpiSwiglu E{HB};
        pg8::gemm_phase<EpiSwiglu, pg8::StaticOrder, true, true>(F.lds + RING_OFF, g, S, E);
        if (BOTH(2)) GRID_BAR();
    }
    if (IN(3)) {
        pg8::Gemm g{HB, (const h16*)(ws + WS_W1B), MTOK, DM, DFF}; pg8::StaticOrder S; S.init(MTOK, DM, F.G, bx);
        EpiResid E{x, out, MOD + 2 * DM, 0.5f};
        pg8::gemm_phase<EpiResid, pg8::StaticOrder, true, true>(F.lds + RING_OFF, g, S, E);
        if (BOTH(3)) GRID_BAR();
    }
    if (IN(4)) { norm_rows<0>(F, out, (const float*)args.in[8], MOD + 3 * DM, MOD + 4 * DM, XN, nullptr); if (BOTH(4)) GRID_BAR(); }
#if MK_MIXER
    if (IN(5)) {
        pg8::Gemm g{XN, (const h16*)(ws + WS_WIN), MTOK, NPROJ, DM}; pg8::StaticOrder S; S.init(MTOK, NPROJ, F.G, bx);
        EpiProj E{ws, (const float*)args.in[10], (LAS float*)(F.lds + XS_OFF)};
        pg8::gemm_phase<EpiProj, pg8::StaticOrder, true, true>(F.lds + RING_OFF, g, S, E);
        if (BOTH(5)) GRID_BAR();
    }
    if (IN(6)) {
#if MK_DSA
        dsa_phase(F, ws);
#endif
        const moba_body::AttnTensors AT{(const moba_body::bf16*)(ws + WS_QB), (const moba_body::bf16*)(ws + WS_KB), (const moba_body::bf16*)(ws + WS_VB), (moba_body::bf16*)(ws + WS_QB), (const float*)(ws + WS_KMEAN)};
        const moba_body::StaticOrder S((int)F.G, bx);
        moba_body::attn_phase<moba_body::StaticOrder>((char*)lds + RING_OFF, AT, S);
        if (BOTH(6)) GRID_BAR();
    }
    if (IN(7)) {
        h16* Y = (h16*)(ws + WS_Y);
#if MK_DSA
        { pg8::Gemm g{(const h16*)(ws + WS_QLAT), (const h16*)(ws + WS_WBA), MTOK, DM, DM}; pg8::StaticOrder S; S.init(MTOK, DM, F.G, bx);
          EpiBranch<false> E{(const h16*)(ws + WS_GA), Y};
          pg8::gemm_phase<EpiBranch<false>, pg8::StaticOrder, true, true>(F.lds + RING_OFF, g, S, E); }
        { pg8::Gemm g{(const h16*)(ws + WS_QB), (const h16*)(ws + WS_WBB), MTOK, DM, 512}; pg8::StaticOrder S; S.init(MTOK, DM, F.G, bx);
          EpiBranch<true> E{(const h16*)(ws + WS_GB), Y};
          pg8::gemm_phase<EpiBranch<true>, pg8::StaticOrder, true, true>(F.lds + RING_OFF, g, S, E); }
#else
        { pg8::Gemm g{(const h16*)(ws + WS_QB), (const h16*)(ws + WS_WBB), MTOK, DM, 512}; pg8::StaticOrder S; S.init(MTOK, DM, F.G, bx);
          EpiBranch<false> E{(const h16*)(ws + WS_GB), Y};
          pg8::gemm_phase<EpiBranch<false>, pg8::StaticOrder, true, true>(F.lds + RING_OFF, g, S, E); }
#endif
        if (BOTH(7)) GRID_BAR();
    }
    if (IN(8)) {
        pg8::Gemm g{(const h16*)(ws + WS_Y), (const h16*)(ws + WS_WO), MTOK, DM, DM}; pg8::StaticOrder S; S.init(MTOK, DM, F.G, bx);
        EpiResid E{out, out, MOD + 5 * DM, 1.0f};
        pg8::gemm_phase<EpiResid, pg8::StaticOrder, true, true>(F.lds + RING_OFF, g, S, E);
        if (BOTH(8)) GRID_BAR();
    }
#else
    if (IN(5)) { if (BOTH(5)) GRID_BAR(); }
    if (IN(6)) { if (BOTH(6)) GRID_BAR(); }
    if (IN(7)) { if (BOTH(7)) GRID_BAR(); }
    if (IN(8)) { if (BOTH(8)) GRID_BAR(); }
#endif
    if (IN(9)) { norm_rows<0>(F, out, (const float*)args.in[16], MOD + 6 * DM, MOD + 7 * DM, XN, nullptr); if (BOTH(9)) GRID_BAR(); }
    if (IN(10)) {
        pg8::Gemm g{XN, (const h16*)(ws + WS_W2A), MTOK, 2 * DFF, DM}; pg8::StaticOrder S; S.init(MTOK, 2 * DFF, F.G, bx);
        EpiSwiglu E{HB};
        pg8::gemm_phase<EpiSwiglu, pg8::StaticOrder, true, true>(F.lds + RING_OFF, g, S, E);
        if (BOTH(10)) GRID_BAR();
    }
    if (IN(11)) {
        pg8::Gemm g{HB, (const h16*)(ws + WS_W2B), MTOK, DM, DFF}; pg8::StaticOrder S; S.init(MTOK, DM, F.G, bx);
        EpiResid E{out, out, MOD + 8 * DM, 0.5f};
        pg8::gemm_phase<EpiResid, pg8::StaticOrder, true, true>(F.lds + RING_OFF, g, S, E);
        if (BOTH(11)) GRID_BAR();
    }
    if (IN(12)) { norm_rows<1>(F, out, (const float*)args.in[19], nullptr, nullptr, nullptr, out); }
#undef IN
#undef BOTH
}

extern "C" void kernel_launch(void* const* d_in, const int* in_sizes, int n_in, void* d_out, int out_size, void* d_ws, size_t ws_size, hipStream_t stream) {
    static int grid = 0;
    if (grid == 0) {
        if (n_in != 20 || in_sizes[0] != MTOK * DM || out_size != MTOK * DM || ws_size < WS_END) { fprintf(stderr, "kernel_launch: unexpected shapes (n_in %d, in0 %d, out %d, ws %zu); nothing launched\n", n_in, n_in > 0 ? in_sizes[0] : -1, out_size, ws_size); grid = -1; return; }
        int dev = 0, cus = 0, per_cu = 0;
        if (hipGetDevice(&dev) != hipSuccess || hipDeviceGetAttribute(&cus, hipDeviceAttributeMultiprocessorCount, dev) != hipSuccess) { grid = -1; return; }
        if (hipFuncSetAttribute((const void*)mega_fwd, hipFuncAttributeMaxDynamicSharedMemorySize, LDS_BYTES) != hipSuccess) { fprintf(stderr, "kernel_launch: hipFuncSetAttribute failed\n"); grid = -1; return; }
        if (hipOccupancyMaxActiveBlocksPerMultiprocessor(&per_cu, (const void*)mega_fwd, NWAVES * 64, LDS_BYTES) != hipSuccess || per_cu < 1) fprintf(stderr, "kernel_launch: occupancy query says %d\n", per_cu);
        (void)hipGetLastError();
        grid = cus;
    }
    if (grid < 0) return;
    if (hipMemsetAsync((char*)d_ws + WS_CTL, 0, CTL_ZERO_BYTES, stream) != hipSuccess) return;
    Args a{};
    for (int i = 0; i < 20; ++i) a.in[i] = d_in[i];
    a.out = (float*)d_out; a.ws = (unsigned char*)d_ws;
#if MK_SPLIT
    for (int p = 0; p < N_PHASES; ++p) { a.ph_lo = p; a.ph_hi = p + 1; hipLaunchKernelGGL(mega_fwd, dim3(grid), dim3(NWAVES * 64), LDS_BYTES, stream, a); }
#else
    a.ph_lo = 0; a.ph_hi = N_PHASES;
    hipLaunchKernelGGL(mega_fwd, dim3(grid), dim3(NWAVES * 64), LDS_BYTES, stream, a);
#endif
}
```

```cpp
#include <hip/hip_runtime.h>
#include <cstdio>
#include <cstdint>
#ifndef PROBE
#define PROBE 0
#endif
namespace pg8 {
#define PG8_LAS __attribute__((address_space(3)))
typedef unsigned short h16_t;
typedef _Float16 f16x8 __attribute__((ext_vector_type(8)));
typedef float f32x4 __attribute__((ext_vector_type(4)));
typedef unsigned u32x4 __attribute__((ext_vector_type(4)));
constexpr int BM = 256, BK = 64, HALF = 128, HTB = HALF * BK * 2  , STAGE_BYTES = 8 * HTB, NXCD = 8, WGM = 8;

__host__ __device__ __forceinline__ int lds_byte(int r, int c) { const int st = (r >> 4) * 2 + (c >> 5), rr = r & 15, cc = c & 31, ob = rr * 64 + cc * 2; return st * 1024 + (ob ^ (((ob >> 9) & 1) << 5)); }
__host__ __device__ __forceinline__ void stage_rc(int b, int& R, int& C) { const int st = b / 1024, sb = b % 1024, swz = sb ^ (((sb >> 9) & 1) << 5); R = (st >> 1) * 16 + swz / 64; C = (st & 1) * 32 + (swz % 64) / 2; }
__host__ __device__ __forceinline__ int perm32(int rho) { const int n = rho >> 4, i = rho & 15; return 8 * (i >> 2) + 4 * n + (i & 3); }

struct Unit { int pm, pn; };
struct Gemm { const h16_t* A; const h16_t* Bt; int M, N, K; };

struct StaticOrder {
    int nM, nN, nwg, G, c;
    __host__ __device__ void init(int M, int N, int G_, int c_) { nM = M / BM; nN = N / BM; nwg = nM * nN; G = G_; c = c_; }
    __host__ __device__ bool next(int i, Unit& u) const {
        const long L = (long)i * G + c; if (L >= nwg) return false;
        int wgid = (int)L; { const int q = nwg / NXCD, r = nwg % NXCD, xcd = wgid % NXCD, off = wgid / NXCD; wgid = (xcd < r ? xcd * (q + 1) : r * (q + 1) + (xcd - r) * q) + off; }
        const int nig = WGM * nN, gid = wgid / nig, fm = gid * WGM, gsz = (nM - fm) < WGM ? (nM - fm) : WGM;
        u.pm = fm + ((wgid % nig) % gsz); u.pn = (wgid % nig) / gsz; return true;
    }
    __device__ __forceinline__ void a_ready(const Unit&) const {}
    __device__ __forceinline__ void done(const Unit&) const {}
};


template <class Epi, class Sched, bool ALIGN_EPI = false, bool SP2 = false>
__device__ __forceinline__ void gemm_phase(PG8_LAS unsigned char* lds, const Gemm g, const Sched& S, const Epi& E, const int tid_hw) {
    const int tid = tid_hw, wid = __builtin_amdgcn_readfirstlane(tid >> 6), lane = tid & 63, wr = wid >> 2, wc = wid & 3, fr = lane & 15, fq = lane >> 4;
    const int K = g.K, nt = K / BK;
    unsigned voffA[2], voffB[2];
#pragma unroll
    for (int i = 0; i < 2; ++i) { int R, C; stage_rc(tid * 16 + i * 8192, R, C); const int Rb = Epi::PERM ? ((R & ~31) + perm32(R & 31)) : R;
        voffA[i] = (unsigned)(R * K + C) * 2u; voffB[i] = (unsigned)(Rb * K + C) * 2u; }
    const size_t kstep = (size_t)(BK * 2);
    const size_t hstep = (size_t)HALF * K * 2;
    const size_t tstep = 2 * hstep;
    const unsigned ldsw = (unsigned)wid * 1024u;
    const int aoff = lds_byte(wr * 64 + fr, fq * 8), boff = lds_byte(wc * 32 + fr, fq * 8);
#define PG8_SA(b, h) (((b) * 2 + (h)) * HTB)
#define PG8_SB(b, h) ((4 + (b) * 2 + (h)) * HTB)
#define PG8_STAGE(bufoff, gbase, voff) do { _Pragma("unroll") for (int _i = 0; _i < 2; ++_i) \
        __builtin_amdgcn_global_load_lds((const unsigned*)((const char*)(gbase) + (voff)[_i]), (PG8_LAS unsigned*)(lds + (bufoff) + ldsw + _i * 8192), 16, 0, 0); } while (0)
#define PG8_LDA(dst, b, h) do { _Pragma("unroll") for (int m = 0; m < 4; ++m) _Pragma("unroll") for (int k = 0; k < 2; ++k) dst[m][k] = *(const PG8_LAS f16x8*)(lds + PG8_SA(b, h) + aoff + m * 2048 + k * 1024); } while (0)
#define PG8_LDB(dst, b, h) do { _Pragma("unroll") for (int n = 0; n < 2; ++n) _Pragma("unroll") for (int k = 0; k < 2; ++k) dst[n][k] = *(const PG8_LAS f16x8*)(lds + PG8_SB(b, h) + boff + n * 2048 + k * 1024); } while (0)
#define PG8_MMA(ai, bj, At, Bt) do { __builtin_amdgcn_s_setprio(1); _Pragma("unroll") for (int m = 0; m < 4; ++m) _Pragma("unroll") for (int n = 0; n < 2; ++n) _Pragma("unroll") for (int k = 0; k < 2; ++k) \
        acc[ai][bj][m][n] = __builtin_amdgcn_mfma_f32_16x16x32_f16(Bt[n][k], At[m][k], acc[ai][bj][m][n], 0, 0, 0); __builtin_amdgcn_s_setprio(0); } while (0)
#define PG8_WAIT_V(n) asm volatile("s_waitcnt vmcnt(" #n ")" ::: "memory")
#define PG8_WAIT_L(n) asm volatile("s_waitcnt lgkmcnt(" #n ")" ::: "memory")
#define PG8_BAR __builtin_amdgcn_s_barrier()
#define PG8_SCHED __builtin_amdgcn_sched_barrier(0)
    Unit cur, nxt; int ui = 0;
    if (!S.next(0, cur)) return;
    f32x4 acc[2][2][4][2];
#pragma unroll
    for (int a = 0; a < 2; ++a)
#pragma unroll
        for (int b = 0; b < 2; ++b)
#pragma unroll
            for (int m = 0; m < 4; ++m)
#pragma unroll
                for (int n = 0; n < 2; ++n) acc[a][b][m][n] = (f32x4){0.f, 0.f, 0.f, 0.f};
    f16x8 At[4][2], B0[2][2], B1[2][2];
    const char* cA = (const char*)g.A + (size_t)cur.pm * tstep; const char* cB = (const char*)g.Bt + (size_t)cur.pn * tstep;
    S.a_ready(cur);
    if constexpr (SP2) {
        PG8_STAGE(PG8_SB(0, 0), cB, voffB); PG8_STAGE(PG8_SB(0, 1), cB + hstep, voffB); PG8_STAGE(PG8_SA(0, 0), cA, voffA); PG8_STAGE(PG8_SA(0, 1), cA + hstep, voffA);
        if (wr == 1) PG8_BAR;
        PG8_WAIT_V(2); PG8_BAR;
        PG8_STAGE(PG8_SB(1, 0), cB + kstep, voffB); PG8_STAGE(PG8_SA(1, 0), cA + kstep, voffA); PG8_STAGE(PG8_SB(1, 1), cB + hstep + kstep, voffB);
        PG8_WAIT_V(6); PG8_BAR;
    } else {
        PG8_STAGE(PG8_SB(0, 0), cB, voffB); PG8_STAGE(PG8_SA(0, 0), cA, voffA); PG8_STAGE(PG8_SB(0, 1), cB + hstep, voffB); PG8_STAGE(PG8_SA(0, 1), cA + hstep, voffA);
        if (wr == 1) PG8_BAR;
        PG8_WAIT_V(4); PG8_BAR;
        PG8_STAGE(PG8_SB(1, 0), cB + kstep, voffB); PG8_STAGE(PG8_SA(1, 0), cA + kstep, voffA); PG8_STAGE(PG8_SB(1, 1), cB + hstep + kstep, voffB);
        PG8_WAIT_V(6); PG8_BAR;
    }
    for (;;) {
        const bool has_next = S.next(ui + 1, nxt);
        const char* nA = has_next ? (const char*)g.A + (size_t)nxt.pm * tstep : cA; const char* nB = has_next ? (const char*)g.Bt + (size_t)nxt.pn * tstep : cB;
        for (int t = 0; t < nt; t += 2) {
            const bool last = (t == nt - 2);
            const char* a1 = cA + (size_t)(t + 1) * kstep;
            const char* a2 = last ? nA : cA + (size_t)(t + 2) * kstep; const char* b2 = last ? nB : cB + (size_t)(t + 2) * kstep;
            const char* a3 = a2 + kstep; const char* b3 = b2 + kstep;
            if (last && has_next) S.a_ready(nxt);
            if constexpr (SP2) {
            PG8_LDB(B0, 0, 0); PG8_LDB(B1, 0, 1); PG8_SCHED; PG8_LDA(At, 0, 0); PG8_STAGE(PG8_SA(1, 1), a1 + hstep, voffA);
            PG8_WAIT_V(8); PG8_WAIT_L(0); PG8_BAR; PG8_MMA(0, 0, At, B0); PG8_MMA(0, 1, At, B1); PG8_BAR; PG8_SCHED;
            PG8_LDA(At, 0, 1); PG8_STAGE(PG8_SB(0, 0), b2, voffB); PG8_STAGE(PG8_SB(0, 1), b2 + hstep, voffB); PG8_STAGE(PG8_SA(0, 0), a2, voffA);
            PG8_WAIT_V(8); PG8_WAIT_L(0); PG8_BAR; PG8_MMA(1, 0, At, B0); PG8_MMA(1, 1, At, B1); PG8_BAR; PG8_SCHED;
            PG8_LDB(B0, 1, 0); PG8_LDB(B1, 1, 1); PG8_SCHED; PG8_LDA(At, 1, 0); PG8_STAGE(PG8_SA(0, 1), a2 + hstep, voffA);
            PG8_WAIT_V(8); PG8_WAIT_L(0); PG8_BAR; PG8_MMA(0, 0, At, B0); PG8_MMA(0, 1, At, B1); PG8_BAR; PG8_SCHED;
            PG8_LDA(At, 1, 1); PG8_STAGE(PG8_SB(1, 0), b3, voffB); PG8_STAGE(PG8_SB(1, 1), b3 + hstep, voffB); PG8_STAGE(PG8_SA(1, 0), a3, voffA);
            PG8_WAIT_V(8); PG8_WAIT_L(0); PG8_BAR; PG8_MMA(1, 0, At, B0); PG8_MMA(1, 1, At, B1); PG8_BAR; PG8_SCHED;
            } else {
            PG8_LDB(B0, 0, 0); PG8_SCHED; PG8_LDA(At, 0, 0); PG8_STAGE(PG8_SA(1, 1), a1 + hstep, voffA);
            PG8_WAIT_L(8); PG8_BAR; PG8_WAIT_L(0); PG8_MMA(0, 0, At, B0); PG8_BAR; PG8_SCHED;
            PG8_LDB(B1, 0, 1); PG8_STAGE(PG8_SB(0, 0), b2, voffB);
            PG8_BAR; PG8_WAIT_L(0); PG8_MMA(0, 1, At, B1); PG8_BAR;
            PG8_LDA(At, 0, 1); PG8_STAGE(PG8_SA(0, 0), a2, voffA);
            PG8_BAR; PG8_WAIT_L(0); PG8_MMA(1, 0, At, B0); PG8_BAR; PG8_SCHED;
            PG8_STAGE(PG8_SB(0, 1), b2 + hstep, voffB);
            PG8_WAIT_V(6); PG8_BAR; PG8_MMA(1, 1, At, B1); PG8_BAR;
            PG8_LDB(B0, 1, 0); PG8_SCHED; PG8_LDA(At, 1, 0); PG8_STAGE(PG8_SA(0, 1), a2 + hstep, voffA);
            PG8_WAIT_L(8); PG8_BAR; PG8_WAIT_L(0); PG8_MMA(0, 0, At, B0); PG8_BAR; PG8_SCHED;
            PG8_LDB(B1, 1, 1); PG8_STAGE(PG8_SB(1, 0), b3, voffB);
            PG8_BAR; PG8_WAIT_L(0); PG8_MMA(0, 1, At, B1); PG8_BAR;
            PG8_LDA(At, 1, 1); PG8_STAGE(PG8_SA(1, 0), a3, voffA);
            PG8_BAR; PG8_WAIT_L(0); PG8_MMA(1, 0, At, B0); PG8_BAR; PG8_SCHED;
            PG8_STAGE(PG8_SB(1, 1), b3 + hstep, voffB);
            PG8_WAIT_V(6); PG8_BAR; PG8_MMA(1, 1, At, B1); PG8_BAR;
            }
        }
        if constexpr (ALIGN_EPI) { if (wr == 0) PG8_BAR; }
        if constexpr (!Epi::AFTER_DRAIN) { E(acc, cur, wr, wc, fr, fq); S.done(cur); }
        if (!has_next) break;
#pragma unroll
        for (int a = 0; a < 2; ++a)
#pragma unroll
            for (int b = 0; b < 2; ++b)
#pragma unroll
                for (int m = 0; m < 4; ++m)
#pragma unroll
                    for (int n = 0; n < 2; ++n) acc[a][b][m][n] = (f32x4){0.f, 0.f, 0.f, 0.f};
        cur = nxt; cA = nA; cB = nB; ++ui;
        if constexpr (ALIGN_EPI) { if (wr == 1) PG8_BAR; }
    }
    PG8_WAIT_V(0);
    if constexpr (!ALIGN_EPI) { if (wr == 0) PG8_BAR; }
    PG8_BAR;
    if constexpr (Epi::AFTER_DRAIN) { E.fused(acc, cur, wr, wc, fr, fq, lds, wid, lane); S.done(cur); }
#undef PG8_SA
#undef PG8_SB
#undef PG8_STAGE
#undef PG8_LDA
#undef PG8_LDB
#undef PG8_MMA
#undef PG8_WAIT_V
#undef PG8_WAIT_L
#undef PG8_BAR
#undef PG8_SCHED
}
}
constexpr int BATCH = 2, SEQ = 8192, DM = 1024, MTOK = BATCH * SEQ;
constexpr int DFF = 2816, NMODV = 9 * DM;
constexpr int NPROJ = 22 * 256;
constexpr int NWAVES = 8;
constexpr float EPS_F = 1e-6f;
constexpr float C2F = 0.18033688011112042f;
#ifndef MK_SPLIT
#define MK_SPLIT 0
#endif
constexpr int N_PHASES = 13;

constexpr size_t KiB = 1024, MiB = 1u << 20;
constexpr size_t WS_CTL = 0, CTL_ZERO_BYTES = 256 * KiB;
constexpr size_t WS_KMEAN = 64 * KiB;
constexpr size_t WS_MOD = 256 * KiB;
constexpr size_t WS_ROPE = 512 * KiB;
constexpr size_t WS_W1A = 2 * MiB, WS_W1B = 13 * MiB, WS_W2A = 19 * MiB, WS_W2B = 30 * MiB, WS_WIN = 36 * MiB, WS_WBA = 47 * MiB, WS_WBB = 49 * MiB, WS_WO = 50 * MiB;
constexpr size_t WS_XN = 52 * MiB;
constexpr size_t WS_H = 84 * MiB;
constexpr size_t WS_QLAT = 84 * MiB, WS_QB = 116 * MiB, WS_KB = 132 * MiB, WS_VB = 148 * MiB, WS_QIDX = 164 * MiB, WS_CKVR = 180 * MiB, WS_QR = 185 * MiB,
                 WS_KIDX = 189 * MiB, WS_WIDX = 191 * MiB, WS_GA = 192 * MiB, WS_GB = 224 * MiB, WS_END = 256 * MiB;
constexpr size_t WS_Y = WS_KB;
static_assert(WS_W1B - WS_W1A >= (size_t)2 * DFF * DM * 2 && WS_W2A - WS_W1B >= (size_t)DM * DFF * 2 && WS_WIN - WS_W2B >= (size_t)DM * DFF * 2 && WS_WBA - WS_WIN >= (size_t)NPROJ * DM * 2, "weights map");
static_assert(WS_H + (size_t)MTOK * DFF * 2 <= WS_END && WS_CKVR + (size_t)MTOK * 320 <= WS_QR && WS_QR + (size_t)MTOK * 256 <= WS_KIDX && WS_KIDX + (size_t)MTOK * 128 <= WS_WIDX, "act map");
constexpr int CW_TMO = 0, CW_CODE = 1, CW_BAR = 4096;

constexpr int RING_OFF = 0, RING_BYTES = 131072;
constexpr int LDSCTL_OFF = RING_BYTES, MISC_OFF = LDSCTL_OFF + 320;
constexpr int XS_OFF = RING_BYTES + 1024, XS_BYTES = 16384;
constexpr int LDS_BYTES = 155648;

#define GAS __attribute__((address_space(1)))
#define LAS __attribute__((address_space(3)))
typedef unsigned short h16;
typedef unsigned v4u __attribute__((ext_vector_type(4)));
typedef unsigned v2u __attribute__((ext_vector_type(2)));
typedef float f32x4 __attribute__((ext_vector_type(4)));
typedef float f32x2 __attribute__((ext_vector_type(2)));
typedef _Float16 f16x2 __attribute__((ext_vector_type(2)));
typedef _Float16 f16x8 __attribute__((ext_vector_type(8)));
typedef GAS unsigned gu32;
typedef GAS unsigned long long gu64;
#define RLX_AGENT __ATOMIC_RELAXED, __HIP_MEMORY_SCOPE_AGENT
#define LDS_WAIT() asm volatile("s_waitcnt lgkmcnt(0)" ::: "memory")
#define VM_WAIT() asm volatile("s_waitcnt vmcnt(0)" ::: "memory")
__device__ __forceinline__ unsigned pkh(float lo, float hi) { f32x2 v = {lo, hi}; f16x2 h = __builtin_convertvector(v, f16x2); return __builtin_bit_cast(unsigned, h); }
__device__ __forceinline__ float h2f(h16 b) { return (float)__builtin_bit_cast(_Float16, b); }
__device__ __forceinline__ float silu_f(float a) { return a * __builtin_amdgcn_rcpf(1.0f + __builtin_amdgcn_exp2f(-1.4426950408889634f * a)); }
__device__ __forceinline__ float sigm_f(float a) { return __builtin_amdgcn_rcpf(1.0f + __builtin_amdgcn_exp2f(-1.4426950408889634f * a)); }
__device__ __forceinline__ int hw_lane() { int l; asm volatile("v_mbcnt_lo_u32_b32 %0, -1, 0\n\tv_mbcnt_hi_u32_b32 %0, -1, %0" : "=v"(l)); return l; }
#define XB_TMO      128
#define XB_XCNT(j)  (256  + 64 * (j))
#define XB_XSUB(j)  (1280 + 64 * (j))
#define XB_XGEN(j)  (2304 + 64 * (j))
#define XB_TOP      3328
#define XB_TOPGEN   3392
#define XCD_BAR_WORDS 3456
#define XB_SPIN_CAP (1u << 18)

__device__ __forceinline__ unsigned xb_ld(unsigned* p)              { return __hip_atomic_load(p, __ATOMIC_RELAXED, __HIP_MEMORY_SCOPE_AGENT); }
__device__ __forceinline__ unsigned xb_add(unsigned* p, unsigned v) { return __hip_atomic_fetch_add(p, v, __ATOMIC_RELAXED, __HIP_MEMORY_SCOPE_AGENT); }
__device__ __forceinline__ unsigned xb_xcc_id() { return (unsigned)__builtin_amdgcn_s_getreg((3 << 11) | 20) & 0xFu; }
#define XB_SPIN(cond, bar) do { unsigned _sp = 0; while (cond) { __builtin_amdgcn_s_sleep(1); \
    if ((++_sp & 255u) == 0u) { if (xb_ld(&(bar)[XB_TMO])) break; if (_sp > XB_SPIN_CAP) { atomicAdd(&(bar)[XB_TMO], 1u); break; } } } } while (0)

struct XcdBarrier {
    unsigned* bar; unsigned x;
    volatile LAS unsigned* st;
};

__device__ __forceinline__ XcdBarrier xcd_barrier_post(unsigned* bar, volatile LAS unsigned* st, const int tid_hw) {
    XcdBarrier b; b.bar = bar; b.x = xb_xcc_id(); b.st = st;
    if (tid_hw == 0) (void)xb_add(&bar[XB_XCNT(b.x)], 1u);
    return b;
}
__device__ __forceinline__ void xcd_barrier_complete(unsigned* bar, unsigned x, unsigned& nloc, unsigned& nx) {
    const unsigned G = gridDim.x * gridDim.y * gridDim.z;
    unsigned sum, cnt, mine, sp = 0u;
    for (;;) {
        sum = 0u; cnt = 0u; mine = 0u;
#pragma unroll
        for (unsigned j = 0; j < 16; ++j) { const unsigned c = xb_ld(&bar[XB_XCNT(j)]); sum += c; cnt += (c > 0u) ? 1u : 0u; mine = (j == x) ? c : mine; }
        if (sum == G) break;
        __builtin_amdgcn_s_sleep(1);
        if ((++sp & 255u) == 0u) { if (xb_ld(&bar[XB_TMO])) break; if (sp > XB_SPIN_CAP) { atomicAdd(&bar[XB_TMO], 1u); break; } }
    }
    nloc = mine > 0u ? mine : 1u; nx = cnt > 0u ? cnt : 1u;
}

__device__ __forceinline__ void xcd_barrier(const XcdBarrier& b, const int tid_hw) {
    asm volatile("s_waitcnt vmcnt(0)" ::: "memory");
    __syncthreads();
    if (tid_hw == 0) {
        unsigned* bar = b.bar;
        __builtin_amdgcn_s_waitcnt(0);
        unsigned nloc = b.st[0], nx = b.st[1];
        if (nloc == 0u) { xcd_barrier_complete(bar, b.x, nloc, nx); b.st[0] = nloc; b.st[1] = nx; }
        const unsigned old = xb_add(&bar[XB_XSUB(b.x)], 1u);
        const unsigned gen = old / nloc;
        if (old + 1u == (gen + 1u) * nloc) {
            __builtin_amdgcn_fence(__ATOMIC_RELEASE, "agent");
            asm volatile("s_waitcnt vmcnt(0)" ::: "memory");
            const unsigned og = xb_add(&bar[XB_TOP], 1u);
            const unsigned tg = og / nx;
            if (og + 1u == (tg + 1u) * nx) xb_add(&bar[XB_TOPGEN], 1u);
            else XB_SPIN(xb_ld(&bar[XB_TOPGEN]) == tg, bar);
            __builtin_amdgcn_fence(__ATOMIC_ACQUIRE, "agent");
            xb_add(&bar[XB_XGEN(b.x)], 1u);
            asm volatile("s_waitcnt vmcnt(0)" ::: "memory");
        } else {
            XB_SPIN(xb_ld(&bar[XB_XGEN(b.x)]) == gen, bar);
            __builtin_amdgcn_fence(__ATOMIC_ACQUIRE, "agent");
            asm volatile("s_waitcnt vmcnt(0)" ::: "memory");
        }
    }
    __syncthreads();
}
using pg8::Unit;
typedef pg8::f32x4 accv;
struct EpiSwiglu {
    static constexpr bool PERM = true, AFTER_DRAIN = false;
    h16* H;
    __device__ __forceinline__ void operator()(const accv (&acc)[2][2][4][2], const Unit& u, int wr, int wc, int fr, int fq) const {
        const int row0 = u.pm * 256 + wr * 64 + fr, col0 = u.pn * 128 + wc * 32 + 8 * fq;
#pragma unroll
        for (int ai = 0; ai < 2; ++ai)
#pragma unroll
            for (int m = 0; m < 4; ++m) {
                h16* rowp = H + (size_t)(row0 + ai * 128 + m * 16) * DFF + col0;
                const accv a0 = acc[ai][0][m][0], a1 = acc[ai][0][m][1], b0 = acc[ai][1][m][0], b1 = acc[ai][1][m][1];
                v4u w;
                w.x = pkh(silu_f(a0[0]) * b0[0], silu_f(a0[1]) * b0[1]); w.y = pkh(silu_f(a0[2]) * b0[2], silu_f(a0[3]) * b0[3]);
                w.z = pkh(silu_f(a1[0]) * b1[0], silu_f(a1[1]) * b1[1]); w.w = pkh(silu_f(a1[2]) * b1[2], silu_f(a1[3]) * b1[3]);
                *(v4u*)rowp = w;
            }
    }
};
struct EpiResid {
    static constexpr bool PERM = false, AFTER_DRAIN = false;
    const float* base; float* out; const float* gate; float factor;
    __device__ __forceinline__ void operator()(const accv (&acc)[2][2][4][2], const Unit& u, int wr, int wc, int fr, int fq) const {
        const int row0 = u.pm * 256 + wr * 64 + fr, col0 = u.pn * 256 + wc * 32 + 4 * fq, b = (u.pm >= 32) ? 1 : 0;
        accv gv[2][2];
#pragma unroll
        for (int bj = 0; bj < 2; ++bj)
#pragma unroll
            for (int n = 0; n < 2; ++n) gv[bj][n] = *(const accv*)(gate + (size_t)b * NMODV + col0 + bj * 128 + n * 16) * factor;
#pragma unroll
        for (int ai = 0; ai < 2; ++ai)
#pragma unroll
            for (int m = 0; m < 4; ++m) {
                const size_t off = (size_t)(row0 + ai * 128 + m * 16) * DM + col0;
#pragma unroll
                for (int bj = 0; bj < 2; ++bj)
#pragma unroll
                    for (int n = 0; n < 2; ++n) {
                        const accv bs = *(const accv*)(base + off + bj * 128 + n * 16);
                        *(accv*)(out + off + bj * 128 + n * 16) = bs + gv[bj][n] * acc[ai][bj][m][n];
                    }
            }
    }
};
__device__ __forceinline__ v4u pack8(const accv& a, const accv& b) { v4u w; w.x = pkh(a[0], a[1]); w.y = pkh(a[2], a[3]); w.z = pkh(b[0], b[1]); w.w = pkh(b[2], b[3]); return w; }
__device__ __forceinline__ v2u pack4(const accv& a) { v2u w; w.x = pkh(a[0], a[1]); w.y = pkh(a[2], a[3]); return w; }
#define UP(base, bytes) ((GAS unsigned char*)(base) + (size_t)(bytes))
struct EpiProj {
    static constexpr bool PERM = true, AFTER_DRAIN = false;
    unsigned char* ws; const float* kvg; LAS float* xs; bool do_km;
    __device__ __forceinline__ void store8(GAS unsigned char* dst, int ld, int colbase, const accv (&acc)[2][2][4][2], int pm, unsigned lrow, int wc, int fq, bool sig) const {
        const unsigned lo = (lrow * (unsigned)ld + (unsigned)(wc * 32 + 8 * fq)) * 2u;
#pragma unroll
        for (int ai = 0; ai < 2; ++ai)
#pragma unroll
            for (int m = 0; m < 4; ++m)
#pragma unroll
                for (int bj = 0; bj < 2; ++bj) {
                    accv a = acc[ai][bj][m][0], b = acc[ai][bj][m][1];
                    if (sig) { for (int e = 0; e < 4; ++e) { a[e] = sigm_f(a[e]); b[e] = sigm_f(b[e]); } }
                    *(GAS v4u*)(UP(dst, ((size_t)(pm * 256 + ai * 128 + m * 16) * ld + colbase + bj * 128) * 2) + lo) = pack8(a, b);
                    __builtin_amdgcn_sched_barrier(0);
                }
    }
    __device__ __forceinline__ void operator()(const accv (&acc)[2][2][4][2], const Unit& u, int wr, int wc, int fr_, int fq_) const {
        int fr = fr_, fq = fq_; asm volatile("" : "+v"(fr), "+v"(fq));
        unsigned char* ws_ = this->ws; asm volatile("" : "+s"(ws_)); GAS unsigned char* const ws = (GAS unsigned char*)ws_;
        const int pn = u.pn, pm = u.pm; const unsigned lrow = (unsigned)(wr * 64 + fr);
        if (pn < 4 || pn == 12 || pn == 13) {
            const bool isv = pn >= 12; store8(isv ? ws + WS_VB : ws + WS_QLAT, isv ? 512 : DM, (isv ? pn - 12 : pn) * 256, acc, pm, lrow, wc, fq, false); return; }
        if (pn >= 14) { const bool isb = pn >= 18; store8(isb ? ws + WS_GB : ws + WS_GA, DM, ((pn - 14) & 3) * 256, acc, pm, lrow, wc, fq, true); return; }
        const unsigned jq = (pn == 5) ? (unsigned)(fq & 1) : (unsigned)(fq & 1) + 0u * 0u;
        const unsigned lo_rope = (lrow * 16u + 4u * ((pn == 5) ? jq : (unsigned)fq)) * 4u;
        GAS unsigned char* const ROPE = ws + WS_ROPE;
#define ROPE_CS(ai, m, c, s) const accv c = *(const GAS accv*)(UP(ROPE, (size_t)(pm * 256 + (ai) * 128 + (m) * 16) * 64) + lo_rope), s = *(const GAS accv*)(UP(ROPE, (size_t)(pm * 256 + (ai) * 128 + (m) * 16) * 64 + 32) + lo_rope)
        if (pn == 4) {
#pragma unroll
            for (int ai = 0; ai < 2; ++ai)
#pragma unroll
                for (int m = 0; m < 4; ++m) { const accv a = acc[ai][0][m][0], b = acc[ai][0][m][1];
                    float s = (a[0] * a[0] + a[1] * a[1]) + (a[2] * a[2] + a[3] * a[3]) + (b[0] * b[0] + b[1] * b[1]) + (b[2] * b[2] + b[3] * b[3]);
                    s += __shfl_xor(s, 16); s += __shfl_xor(s, 32);
                    if (fq == 0) xs[(ai * 128 + m * 16 + (int)lrow) * 4 + wc] = s; }
            asm volatile("s_waitcnt lgkmcnt(0)" ::: "memory"); __builtin_amdgcn_s_barrier(); asm volatile("" ::: "memory");
            GAS unsigned char* const CK = ws + WS_CKVR; GAS unsigned char* const KI = ws + WS_KIDX; GAS unsigned char* const WI = ws + WS_WIDX;
            const accv g0 = *(const accv*)(kvg + wc * 32 + 8 * fq), g1 = *(const accv*)(kvg + wc * 32 + 8 * fq + 4);
            const unsigned lo_ck = (lrow * 160u + (unsigned)(wc * 32 + 8 * fq)) * 2u, lo_ki = (lrow * 64u) * 2u, lo_ckr = (lrow * 160u) * 2u, lo_wi = lrow * 32u;
#pragma unroll
            for (int ai = 0; ai < 2; ++ai)
#pragma unroll
                for (int m = 0; m < 4; ++m) { const int rl = ai * 128 + m * 16; const size_t rg = (size_t)(pm * 256 + rl);
                    const f32x4 p = *(const LAS f32x4*)(xs + (rl + (int)lrow) * 4);
                    const float rstd = 1.0f / sqrtf(((p[0] + p[1]) + (p[2] + p[3])) * (1.0f / 128.0f) + EPS_F);
                    *(GAS v4u*)(UP(CK, rg * 320) + lo_ck) = pack8(acc[ai][0][m][0] * rstd * g0, acc[ai][0][m][1] * rstd * g1);
                    const accv a = acc[ai][1][m][0], b = acc[ai][1][m][1];
                    if (wc == 0) {
                        if (fq < 2) { ROPE_CS(ai, m, c, s);
                            *(GAS v2u*)(UP(KI, rg * 128) + lo_ki + 8u * fq) = pack4(a * c - b * s); *(GAS v2u*)(UP(KI, rg * 128 + 16) + lo_ki + 8u * fq) = pack4(b * c + a * s); }
                        else *(GAS v4u*)(UP(KI, rg * 128) + lo_ki + 16u * fq) = pack8(a, b);
                    } else if (wc == 1) { *(GAS v4u*)(UP(KI, rg * 128 + 64) + lo_ki + 16u * fq) = pack8(a, b);
                    } else if (wc == 2) {
                        if (fq < 2) { ROPE_CS(ai, m, c, s);
                            *(GAS v2u*)(UP(CK, rg * 320 + 256) + lo_ckr + 8u * fq) = pack4(a * c - b * s); *(GAS v2u*)(UP(CK, rg * 320 + 272) + lo_ckr + 8u * fq) = pack4(b * c + a * s); }
                        else if (fq == 2) { *(GAS accv*)(UP(WI, rg * 32) + lo_wi) = a * 0.044194173824159216f; *(GAS accv*)(UP(WI, rg * 32 + 16) + lo_wi) = b * 0.044194173824159216f; }
                        else { const v4u z = {0u, 0u, 0u, 0u}; *(GAS v4u*)(UP(CK, rg * 320 + 288) + lo_ckr) = z; *(GAS v4u*)(UP(CK, rg * 320 + 304) + lo_ckr) = z; }
                    }
                    asm volatile("" ::: "memory"); __builtin_amdgcn_sched_barrier(0);
                }
            return;
        }
        if (pn == 5) {
            GAS unsigned char* const QR = ws + WS_QR; const unsigned lo_qr = (lrow * 128u + (unsigned)((2 * wc + (fq >> 1)) * 16) + 4u * jq) * 2u;
#pragma unroll
            for (int ai = 0; ai < 2; ++ai)
#pragma unroll
                for (int m = 0; m < 4; ++m) { const size_t rg = (size_t)(pm * 256 + ai * 128 + m * 16); const accv a = acc[ai][0][m][0], b = acc[ai][0][m][1];
                    ROPE_CS(ai, m, c, s);
                    *(GAS v2u*)(UP(QR, rg * 256) + lo_qr) = pack4(a * c - b * s); *(GAS v2u*)(UP(QR, rg * 256 + 16) + lo_qr) = pack4(b * c + a * s); asm volatile("" ::: "memory"); }
            return;
        }
        {
            GAS unsigned char* const dst = ws + ((pn < 8) ? WS_QIDX : (pn < 10) ? WS_QB : WS_KB); const bool isk = pn >= 10;
            float* const KM = (float*)(ws_ + WS_KMEAN) + (size_t)pm * 512;
            const unsigned lo_d = (lrow * 512u + (unsigned)((wc >> 1) * 64)) * 2u;
#pragma unroll
            for (int bj = 0; bj < 2; ++bj) {
                const int hb = 4 * (pn & 1) + 2 * bj;
                accv csum0 = {0.f, 0.f, 0.f, 0.f}, csum1 = {0.f, 0.f, 0.f, 0.f};
#pragma unroll
                for (int ai = 0; ai < 2; ++ai)
#pragma unroll
                    for (int m = 0; m < 4; ++m) { const size_t rg = (size_t)(pm * 256 + ai * 128 + m * 16); accv a = acc[ai][bj][m][0], b = acc[ai][bj][m][1];
                        GAS unsigned char* const rb = UP(dst, (rg * 512 + hb * 64) * 2);
                        if ((wc & 1) == 0) {
                            if (fq < 2) { ROPE_CS(ai, m, c, s);
                                const accv ra = a * c - b * s, rbv = b * c + a * s; a = ra; b = rbv;
                                *(GAS v2u*)(rb + lo_d + 8u * fq) = pack4(a); *(GAS v2u*)(rb + 16 + lo_d + 8u * fq) = pack4(b); }
                            else *(GAS v4u*)(rb + lo_d + 16u * fq) = pack8(a, b);
                        } else *(GAS v4u*)(rb + 64 + lo_d + 16u * fq) = pack8(a, b);
                        csum0 += a; csum1 += b; asm volatile("" ::: "memory"); __builtin_amdgcn_sched_barrier(0); }
                if (isk && do_km) {
#pragma unroll
                    for (int e = 0; e < 4; ++e) {
#pragma unroll
                        for (int o = 1; o < 16; o <<= 1) { csum0[e] += __shfl_xor(csum0[e], o); csum1[e] += __shfl_xor(csum1[e], o); } }
                    if (fr == 0) {
                        int ch0, ch1;
                        if ((wc & 1) == 0) { if (fq < 2) { ch0 = 4 * fq; ch1 = 8 + 4 * fq; } else { ch0 = 8 * fq; ch1 = 8 * fq + 4; } } else { ch0 = 32 + 8 * fq; ch1 = 36 + 8 * fq; }
                        float* kb_ = KM + (hb + (wc >> 1)) * 64;
#pragma unroll
                        for (int e = 0; e < 4; ++e) { atomicAdd(kb_ + ch0 + e, csum0[e]); atomicAdd(kb_ + ch1 + e, csum1[e]); }
                    }
                }
            }
        }
#undef ROPE_CS
    }
};
template <bool ADD>
struct EpiBranch {
    static constexpr bool PERM = true, AFTER_DRAIN = false;
    const h16* G; h16* Y;
    __device__ __forceinline__ void operator()(const accv (&acc)[2][2][4][2], const Unit& u, int wr, int wc, int fr, int fq) const {
        const int row0 = u.pm * 256 + wr * 64 + fr;
#pragma unroll
        for (int ai = 0; ai < 2; ++ai)
#pragma unroll
            for (int m = 0; m < 4; ++m)
#pragma unroll
                for (int bj = 0; bj < 2; ++bj) {
                    const size_t off = (size_t)(row0 + ai * 128 + m * 16) * DM + u.pn * 256 + bj * 128 + wc * 32 + 8 * fq;
                    const f16x8 g = __builtin_bit_cast(f16x8, *(const v4u*)(G + off));
                    accv a = acc[ai][bj][m][0], b = acc[ai][bj][m][1];
#pragma unroll
                    for (int e = 0; e < 4; ++e) { a[e] *= (float)g[e]; b[e] *= (float)g[4 + e]; }
                    if (ADD) { const f16x8 y = __builtin_bit_cast(f16x8, *(const v4u*)(Y + off));
#pragma unroll
                        for (int e = 0; e < 4; ++e) { a[e] += (float)y[e]; b[e] += (float)y[4 + e]; } }
                    *(v4u*)(Y + off) = pack8(a, b);
                }
    }
};
namespace moba_body {
using bf16=unsigned short;
using bf16x8=__attribute__((ext_vector_type(8)))_Float16;
using s16x8=__attribute__((ext_vector_type(8)))short;
using s16x4=__attribute__((ext_vector_type(4)))short;
using f32x16=__attribute__((ext_vector_type(16)))float;
using u32x4=__attribute__((ext_vector_type(4)))unsigned;
constexpr int BATCH=2,NHEAD=8,SEQ=8192,D=64,DM=NHEAD*D;
constexpr int NW=8,QBLK=32,QB=QBLK*NW,KVBLK=64,NQB=SEQ/QB;
constexpr int ATTN_PITCH=DM, ATTN_UNIT_ROWS=QB;
__device__ __forceinline__ int crow(int r,int hi){return (r&3)+8*(r>>2)+4*hi;}
#define SBAR() __builtin_amdgcn_sched_barrier(0)
__device__ __forceinline__ void cmask(f32x16&p0,f32x16&p1,int jb,int qrel,int hi){
  const float NEG=-INFINITY; int kb=64*jb+4*hi;
  #pragma unroll
  for(int r=0;r<16;++r){int kv=kb+(r&3)+8*(r>>2); if(kv>qrel)p0[r]=NEG; if(kv+32>qrel)p1[r]=NEG;}
}

constexpr float NEGS=-1000.0f;
__device__ __forceinline__ void selm(f32x16&p0,f32x16&p1,unsigned selmask,int t){
  const bool keep=((selmask>>(t>>2))&1u)!=0u;
  #pragma unroll
  for(int r=0;r<16;++r){p0[r]=keep?p0[r]:NEGS;p1[r]=keep?p1[r]:NEGS;}
}
constexpr int NSLOT=3, SLOTB=8192;
constexpr int LDS_K=0, LDS_V=NSLOT*SLOTB, LDS_WS=2*NSLOT*SLOTB, LDS_OST=LDS_WS+NW*64*4, LDS_BYTES=LDS_OST+NW*4096;
constexpr float C2=0.125f*1.4426950408889634f;
__device__ __forceinline__ void glds16(const void*gsrc,unsigned lds_dst){unsigned keep;
  asm volatile("s_mov_b32 %0, m0\n\ts_mov_b32 m0, %2\n\ts_nop 0\n\tglobal_load_lds_dwordx4 %1, off\n\ts_mov_b32 m0, %0":"=&s"(keep):"v"(gsrc),"s"(lds_dst):"memory");}
__device__ __forceinline__ float max3f(float a,float b,float c){float r;asm("v_max3_f32 %0, %1, %2, %3":"=v"(r):"v"(a),"v"(b),"v"(c));return r;}
__device__ __forceinline__ float max2f(float a,float b){float r;asm("v_max_f32_e32 %0, %1, %2":"=v"(r):"v"(a),"v"(b));return r;}
__device__ __forceinline__ float fadd_s(float a,float b){float r;asm("v_add_f32_e32 %0, %1, %2":"=v"(r):"v"(a),"v"(b));return r;}
__device__ __forceinline__ float fsub_s(float a,float b){float r;asm("v_sub_f32_e32 %0, %1, %2":"=v"(r):"v"(a),"v"(b));return r;}
typedef float f32x2_t __attribute__((ext_vector_type(2))); typedef _Float16 bf16x2_t __attribute__((ext_vector_type(2)));
__device__ __forceinline__ unsigned cvtpk_s(float lo,float hi){f32x2_t v={lo,hi};bf16x2_t b=__builtin_convertvector(v,bf16x2_t);return __builtin_bit_cast(unsigned,b);}
#define WAIT_BAR(N) asm volatile("s_waitcnt vmcnt(" #N ") lgkmcnt(0)\n\ts_barrier":::"memory")

__device__ __forceinline__ void qkt(f32x16&p0,f32x16&p1,const char*Kslot,const bf16x8*qr,const f32x16&negm,int r32,int hi){
  const char*kb=Kslot+hi*1024+r32*16;
  #pragma unroll
  for(int d0=0;d0<4;++d0){
    const bf16x8 b0=*reinterpret_cast<const bf16x8*>(kb+d0*2048);
    const bf16x8 b1=*reinterpret_cast<const bf16x8*>(kb+d0*2048+512);
    if(d0==0){p0=__builtin_amdgcn_mfma_f32_32x32x16_f16(b0,qr[0],negm,0,0,0);p1=__builtin_amdgcn_mfma_f32_32x32x16_f16(b1,qr[0],negm,0,0,0);}
    else{p0=__builtin_amdgcn_mfma_f32_32x32x16_f16(b0,qr[d0],p0,0,0,0);p1=__builtin_amdgcn_mfma_f32_32x32x16_f16(b1,qr[d0],p1,0,0,0);}}
}
typedef __attribute__((address_space(3))) const char* lds_cptr;
typedef short v4i16_t __attribute__((ext_vector_type(4)));
__device__ __forceinline__ void kload8(bf16x8*kf,lds_cptr kp){
  kf[0]=*(const __attribute__((address_space(3))) bf16x8*)(kp);      kf[1]=*(const __attribute__((address_space(3))) bf16x8*)(kp+512);
  kf[2]=*(const __attribute__((address_space(3))) bf16x8*)(kp+2048); kf[3]=*(const __attribute__((address_space(3))) bf16x8*)(kp+2560);
  kf[4]=*(const __attribute__((address_space(3))) bf16x8*)(kp+4096); kf[5]=*(const __attribute__((address_space(3))) bf16x8*)(kp+4608);
  kf[6]=*(const __attribute__((address_space(3))) bf16x8*)(kp+6144); kf[7]=*(const __attribute__((address_space(3))) bf16x8*)(kp+6656);
}
__device__ __forceinline__ void kload2(bf16x8*kf,lds_cptr kp,int j){ kf[2*j]=*(const __attribute__((address_space(3))) bf16x8*)(kp+j*2048); kf[2*j+1]=*(const __attribute__((address_space(3))) bf16x8*)(kp+j*2048+512); }
__device__ __forceinline__ s16x4 vtr(lds_cptr p){ return __builtin_bit_cast(s16x4,__builtin_amdgcn_ds_read_tr16_b64_v4i16((__attribute__((address_space(3))) v4i16_t*)p)); }
__device__ __forceinline__ float rowmax(const f32x16&p0,const f32x16&p1){
  float a=max3f(p0[0],p0[1],p1[0]),b=max3f(p0[2],p0[3],p1[1]);a=max3f(a,p1[2],p1[3]);
  #pragma unroll
  for(int r=4;r<16;r+=4){a=max3f(a,p0[r],p0[r+1]);b=max3f(b,p0[r+2],p0[r+3]);a=max3f(a,p1[r],p1[r+1]);b=max3f(b,p1[r+2],p1[r+3]);}
  const float m=max2f(a,b);
  auto rr=__builtin_amdgcn_permlane32_swap(__float_as_uint(m),__float_as_uint(m),false,false);
  return max2f(__uint_as_float(rr[0]),__uint_as_float(rr[1]));
}
__device__ __forceinline__ void pv(f32x16*o,int vb,bf16x8 pa0,bf16x8 pa1,bf16x8 pa2,bf16x8 pa3){
  #pragma unroll
  for(int d0=0;d0<2;++d0){s16x4 lo[4],hi[4];
    #pragma unroll
    for(int ks=0;ks<4;++ks){
      asm volatile("ds_read_b64_tr_b16 %0,%1 offset:%c2":"=&v"(lo[ks]):"v"(vb),"i"(d0*4096+ks*1024):"memory");
      asm volatile("ds_read_b64_tr_b16 %0,%1 offset:%c2":"=&v"(hi[ks]):"v"(vb),"i"(d0*4096+ks*1024+512):"memory");}
    asm volatile("s_waitcnt lgkmcnt(0)":::"memory");SBAR();
    #define PK(k) __builtin_bit_cast(bf16x8,(s16x8){lo[k][0],lo[k][1],lo[k][2],lo[k][3],hi[k][0],hi[k][1],hi[k][2],hi[k][3]})
    o[d0]=__builtin_amdgcn_mfma_f32_32x32x16_f16(pa0,PK(0),o[d0],0,0,0);
    o[d0]=__builtin_amdgcn_mfma_f32_32x32x16_f16(pa1,PK(1),o[d0],0,0,0);
    o[d0]=__builtin_amdgcn_mfma_f32_32x32x16_f16(pa2,PK(2),o[d0],0,0,0);
    o[d0]=__builtin_amdgcn_mfma_f32_32x32x16_f16(pa3,PK(3),o[d0],0,0,0);
    #undef PK
  }
}

#ifndef ATTN_STORE16
#define ATTN_STORE16(p,v) (*(u32x4*)(p)=(v))
#endif
template<int THRL> __device__ __forceinline__ void attn_unit(int b,int h,int qb,const bf16*Q,const bf16*__restrict__ K,const bf16*__restrict__ V,bf16*O,const float*__restrict__ KMEAN,char*shm,const int tid_hw){
  const int tid=tid_hw,lane=tid&63,r32=lane&31,hi=lane>>5; const int wid=__builtin_amdgcn_readfirstlane(tid>>6);
  const long rowbase=(long)b*SEQ; const int q0=qb*QB;
  const bf16*Qw=Q+(rowbase+q0+wid*QBLK)*DM+h*D;
  unsigned selmask=0u;
  if(qb>0){
    float qf[64];
    { const u32x4*qp=reinterpret_cast<const u32x4*>(&Qw[(long)r32*DM]);
      #pragma unroll
      for(int c=0;c<8;++c){ const u32x4 w=qp[c]; const bf16x8 hv=__builtin_bit_cast(bf16x8,w);
        #pragma unroll
        for(int e=0;e<8;++e)qf[c*8+e]=(float)hv[e]; } }
    float v1=-INFINITY,v2=-INFINITY,v3=-INFINITY; int i1=-1,i2=-1,i3=-1;
    for(int j=0;j<qb;++j){
      const float*km=KMEAN+((long)(b*32+j)*DM+h*D);
      float g0=0.f,g1=0.f,g2=0.f,g3=0.f;
      #pragma unroll
      for(int d=0;d<64;d+=4){g0+=qf[d]*km[d];g1+=qf[d+1]*km[d+1];g2+=qf[d+2]*km[d+2];g3+=qf[d+3]*km[d+3];}
      const float g=(g0+g1)+(g2+g3);
      const bool c1=g>v1,c2=g>v2,c3=g>v3;
      v3=c2?v2:(c3?g:v3); i3=c2?i2:(c3?j:i3);
      v2=c1?v1:(c2?g:v2); i2=c1?i1:(c2?j:i2);
      v1=c1?g:v1; i1=c1?j:i1;
    }
    if(i1>=0)selmask|=1u<<i1; if(i2>=0)selmask|=1u<<i2; if(i3>=0)selmask|=1u<<i3;
  }
  const bf16*Kh=K+rowbase*DM+h*D,*Vh=V+rowbase*DM+h*D;
  const unsigned lds0=(unsigned)(uintptr_t)shm;
  float*wsf=(float*)(shm+LDS_WS)+wid*64;
  const bf16*ksrc=Kh+(long)lane*DM+wid*8;
  const bf16*vsrc=Vh+(long)(16*(wid&3)+(lane>>2))*DM+(wid>>2)*32+(lane&3)*8;
  const unsigned kdst=lds0+LDS_K+wid*1024, vdst=lds0+LDS_V+wid*1024;
  #define DMA_K(t,slot) glds16(ksrc+(long)(t)*KVBLK*DM,(unsigned)__builtin_amdgcn_readfirstlane(kdst+(slot)))
  #define DMA_V(t,slot) glds16(vsrc+(long)(t)*KVBLK*DM,(unsigned)__builtin_amdgcn_readfirstlane(vdst+(slot)))
  const int vb0=(int)(lds0+LDS_V)+((lane>>4)&1)*32+(lane&3)*8+(4*hi+((lane&15)>>2))*64;
  const char*Kbase=shm+LDS_K; bf16x8 kf[8];
  const lds_cptr shm3=(lds_cptr)shm; const lds_cptr kp0=shm3+LDS_K+hi*1024+r32*16; const lds_cptr vp0=shm3+LDS_V+((lane>>4)&1)*32+(lane&3)*8+(4*hi+((lane&15)>>2))*64;
  const int NT=(q0+QB)/KVBLK;
  DMA_K(0,0);DMA_V(0,0);DMA_K(1,SLOTB);
  bf16x8 qr[4];
  #pragma unroll
  for(int d0=0;d0<4;++d0)qr[d0]=*reinterpret_cast<const bf16x8*>(&Qw[(long)r32*DM+d0*16+hi*8]);
  float mhat=0.f,l_reg=0.f;f32x16 o[2];o[0]=f32x16{};o[1]=f32x16{};f32x16 negm=f32x16{};asm volatile("":"+v"(negm));
  const int qrel=wid*QBLK+r32;
  #define CMASK(P0,P1,t) do{int jb_=(t)-(NT-4); if(jb_>=0)cmask(P0,P1,jb_,qrel,hi); else selm(P0,P1,selmask,(t));}while(0)
  bool resc=false;
  #define START(P0,P1) do{ const float rm=rowmax(P0,P1); resc=false; \
    { const float dl=rm; mhat=fadd_s(mhat,dl); \
      _Pragma("unroll") for(int r=0;r<16;++r){P0[r]=fsub_s(P0[r],dl);P1[r]=fsub_s(P1[r],dl);} \
      _Pragma("unroll") for(int r=0;r<16;++r)negm[r]=-mhat; asm volatile("":"+v"(negm)); } \
    _Pragma("unroll") for(int r=0;r<16;++r)P0[r]=__builtin_amdgcn_exp2f(P0[r]); }while(0)
  #define RESC() do{ if(resc){ asm volatile("s_waitcnt lgkmcnt(0)":::"memory"); \
      _Pragma("unroll") for(int d_=0;d_<2;++d_) _Pragma("unroll") for(int r=0;r<16;++r)o[d_][r]*=wsf[crow(r,hi)]; } }while(0)
  f32x16 pA0,pA1,pB0,pB1;
  int sl_prev=0,sl_cur=0,sl_next=SLOTB;
  #define ROT() do{sl_prev=sl_cur;sl_cur=sl_next;sl_next=(sl_next==(NSLOT-1)*SLOTB)?0:sl_next+SLOTB;}while(0)
  DMA_K(2,2*SLOTB);
  WAIT_BAR(3);
  qkt(pA0,pA1,Kbase,qr,negm,r32,hi);asm volatile("s_nop 15\n\ts_nop 7":"+v"(pA0),"+v"(pA1));CMASK(pA0,pA1,0);
  START(pA0,pA1);
  _Pragma("unroll") for(int r=0;r<16;++r)pA1[r]=__builtin_amdgcn_exp2f(pA1[r]);
  WAIT_BAR(0);
  DMA_K(3,0);DMA_V(1,SLOTB);
  ROT();
  kload8(kf,kp0+sl_cur);
  WAIT_BAR(2);
  s16x4 vlo[8],vhi[8]; u32x4 pw0,pw1,pw2,pw3;
  #define PKW(P,B) cvtpk_s(P[B],P[B+1])
  #define PAF(k) __builtin_bit_cast(bf16x8,pw##k)
  #define VFR(i) __builtin_bit_cast(bf16x8,(s16x8){vlo[i][0],vlo[i][1],vlo[i][2],vlo[i][3],vhi[i][0],vhi[i][1],vhi[i][2],vhi[i][3]})
  #define PIN(x) asm volatile("":"+v"(x))
  #define MX3(a,b,c) __builtin_fmaxf(__builtin_fmaxf((a),(b)),(c))
  #define GAPA(MF,A0,A1,A2,A3,W0,W1,PW) do{ MF; sacc+=A0; sacc+=A1; sacc+=A2; sacc+=A3; PIN(sacc); W0; W1; PIN(PW); SBAR(); }while(0)
  #define EX(v) __builtin_amdgcn_exp2f(v)
  #define GAPB(MF,X,B) do{ MF; X[B]=EX(X[B]); X[B+1]=EX(X[B+1]); X[B+2]=EX(X[B+2]); X[B+3]=EX(X[B+3]); PIN(X); SBAR(); }while(0)
  #define VRD(i) do{ vlo[i]=vtr(vp_+(((i)>>2)*4096+((i)&3)*1024)); vhi[i]=vtr(vp_+(((i)>>2)*4096+((i)&3)*1024+512)); }while(0)
  #define KRD(G,j) do{ if(G){ kload2(kf,kp0+sl_next,j); SBAR(); } }while(0)
  #define STEP(C0,C1,P0,P1,t,GK,GV,GL) do{ SBAR(); \
    const lds_cptr vp_=vp0+sl_prev; \
    VRD(0); SBAR(); float sacc=(P0[0]+P0[1]); \
    GAPA(C0=__builtin_amdgcn_mfma_f32_32x32x16_f16(kf[0],qr[0],negm,0,0,0), P0[2],P0[3],P0[4],P0[5],     pw0[0]=PKW(P0,0), pw0[1]=PKW(P0,2), pw0); \
    VRD(4); SBAR(); GAPA(C1=__builtin_amdgcn_mfma_f32_32x32x16_f16(kf[1],qr[0],negm,0,0,0), P0[6],P0[7],P0[8],P0[9],     pw0[2]=PKW(P0,4), pw0[3]=PKW(P0,6), pw0); \
    VRD(1); SBAR(); GAPA(C0=__builtin_amdgcn_mfma_f32_32x32x16_f16(kf[2],qr[1],C0,0,0,0),   P0[10],P0[11],P0[12],P0[13], pw1[0]=PKW(P0,8), pw1[1]=PKW(P0,10), pw1); \
    VRD(5); SBAR(); GAPA(C1=__builtin_amdgcn_mfma_f32_32x32x16_f16(kf[3],qr[1],C1,0,0,0),   P0[14],P0[15],P1[0],P1[1],   pw1[2]=PKW(P0,12),pw1[3]=PKW(P0,14), pw1); \
    VRD(2); SBAR(); GAPA(C0=__builtin_amdgcn_mfma_f32_32x32x16_f16(kf[4],qr[2],C0,0,0,0),   P1[2],P1[3],P1[4],P1[5],     pw2[0]=PKW(P1,0), pw2[1]=PKW(P1,2), pw2); \
    VRD(6); SBAR(); GAPA(C1=__builtin_amdgcn_mfma_f32_32x32x16_f16(kf[5],qr[2],C1,0,0,0),   P1[6],P1[7],P1[8],P1[9],     pw2[2]=PKW(P1,4), pw2[3]=PKW(P1,6), pw2); \
    VRD(3); SBAR(); GAPA(C0=__builtin_amdgcn_mfma_f32_32x32x16_f16(kf[6],qr[3],C0,0,0,0),   P1[10],P1[11],P1[12],P1[13], pw3[0]=PKW(P1,8), pw3[1]=PKW(P1,10), pw3); \
    VRD(7); SBAR(); GAPA(C1=__builtin_amdgcn_mfma_f32_32x32x16_f16(kf[7],qr[3],C1,0,0,0),   P1[14],P1[15],0.f,0.f,       pw3[2]=PKW(P1,12),pw3[3]=PKW(P1,14), pw3); \
    l_reg+=sacc; \
    if(GK){DMA_K((t)+3,sl_cur);} if(GV){DMA_V((t)+1,sl_next);} \
    CMASK(C0,C1,t); \
    { float a=MX3(C0[0],C0[1],C1[0]),b=MX3(C0[2],C0[3],C1[1]); a=MX3(a,C1[2],C1[3]); \
      _Pragma("unroll") for(int r=4;r<16;r+=4){a=MX3(a,C0[r],C0[r+1]);b=MX3(b,C0[r+2],C0[r+3]);a=MX3(a,C1[r],C1[r+1]);b=MX3(b,C1[r+2],C1[r+3]);} \
      float rm=__builtin_fmaxf(a,b); { auto rr=__builtin_amdgcn_permlane32_swap(__float_as_uint(rm),__float_as_uint(rm),false,false); rm=__builtin_fmaxf(__uint_as_float(rr[0]),__uint_as_float(rr[1])); } \
      resc=false; \
      if(__builtin_expect(__any(rm>(float)THRL),0)){ const float dl=__builtin_fmaxf(rm,0.f); mhat+=dl; \
        _Pragma("unroll") for(int r=0;r<16;++r){C0[r]-=dl;C1[r]-=dl;} \
        _Pragma("unroll") for(int r=0;r<16;++r)negm[r]=-mhat; asm volatile("":"+v"(negm)); \
        const float f=__builtin_amdgcn_exp2f(-dl); l_reg*=f; if(hi==0)wsf[r32]=f; resc=true; } } \
    SBAR(); \
    GAPB(o[0]=__builtin_amdgcn_mfma_f32_32x32x16_f16(PAF(0),VFR(0),o[0],0,0,0), C0,0); \
    GAPB(o[1]=__builtin_amdgcn_mfma_f32_32x32x16_f16(PAF(0),VFR(4),o[1],0,0,0), C0,4); \
    KRD(GL,0); GAPB(o[0]=__builtin_amdgcn_mfma_f32_32x32x16_f16(PAF(1),VFR(1),o[0],0,0,0), C0,8); \
    KRD(GL,1); GAPB(o[1]=__builtin_amdgcn_mfma_f32_32x32x16_f16(PAF(1),VFR(5),o[1],0,0,0), C0,12); \
    KRD(GL,2); GAPB(o[0]=__builtin_amdgcn_mfma_f32_32x32x16_f16(PAF(2),VFR(2),o[0],0,0,0), C1,0); \
    KRD(GL,3); GAPB(o[1]=__builtin_amdgcn_mfma_f32_32x32x16_f16(PAF(2),VFR(6),o[1],0,0,0), C1,4); \
    GAPB(o[0]=__builtin_amdgcn_mfma_f32_32x32x16_f16(PAF(3),VFR(3),o[0],0,0,0), C1,8); \
    GAPB(o[1]=__builtin_amdgcn_mfma_f32_32x32x16_f16(PAF(3),VFR(7),o[1],0,0,0), C1,12); \
    }while(0)
  int t=1;
  #undef CMASK
  #define CMASK(P0,P1,t) selm(P0,P1,selmask,(t))
  for(;t+5<NT;t+=2){
    STEP(pB0,pB1,pA0,pA1,t,true,true,true);     WAIT_BAR(2); RESC(); ROT();
    STEP(pA0,pA1,pB0,pB1,t+1,true,true,true);   WAIT_BAR(2); RESC(); ROT();
  }
  #undef CMASK
  #define CMASK(P0,P1,t) do{int jb_=(t)-(NT-4); if(jb_>=0)cmask(P0,P1,jb_,qrel,hi); else selm(P0,P1,selmask,(t));}while(0)
  #define ENDW(tt) do{ if((tt)+3<NT){WAIT_BAR(2);} else if((tt)+2<NT){WAIT_BAR(1);} else {WAIT_BAR(0);} }while(0)
  for(;t+1<NT;t+=2){
    STEP(pB0,pB1,pA0,pA1,t,(t+3<NT),(t+1<NT),(t+1<NT));       ENDW(t);   RESC(); ROT();
    STEP(pA0,pA1,pB0,pB1,t+1,(t+4<NT),(t+2<NT),(t+2<NT));     ENDW(t+1); RESC(); ROT();
  }
  STEP(pB0,pB1,pA0,pA1,NT-1,false,false,false); RESC();
  { float sacc=pB0[0]+pB0[1]; _Pragma("unroll") for(int r=2;r<16;++r)sacc+=pB0[r]; _Pragma("unroll") for(int r=0;r<16;++r)sacc+=pB1[r]; l_reg+=sacc;
    pw0=(u32x4){PKW(pB0,0),PKW(pB0,2),PKW(pB0,4),PKW(pB0,6)};pw1=(u32x4){PKW(pB0,8),PKW(pB0,10),PKW(pB0,12),PKW(pB0,14)};pw2=(u32x4){PKW(pB1,0),PKW(pB1,2),PKW(pB1,4),PKW(pB1,6)};pw3=(u32x4){PKW(pB1,8),PKW(pB1,10),PKW(pB1,12),PKW(pB1,14)};
    SBAR(); pv(o,vb0+sl_cur,PAF(0),PAF(1),PAF(2),PAF(3)); }
  #undef PKW
  #undef PAF
  #undef VFR
  #undef PIN
  #undef MX3
  #undef GAPA
  #undef GAPB
  #undef EX
  #undef VRD
  #undef KRD
  #undef STEP
  #undef ENDW
  {auto rr=__builtin_amdgcn_permlane32_swap(__float_as_uint(l_reg),__float_as_uint(l_reg),false,false);l_reg=__uint_as_float(rr[0])+__uint_as_float(rr[1]);}
  if(hi==0)wsf[32+r32]=l_reg;asm volatile("s_waitcnt lgkmcnt(0)":::"memory");
  float rli[16];
  #pragma unroll
  for(int r=0;r<16;++r)rli[r]=__builtin_amdgcn_rcpf(wsf[32+crow(r,hi)]);
  bf16*Ow=O+(rowbase+q0+wid*QBLK)*DM+h*D;
  { bf16*stg=(bf16*)(shm+LDS_OST)+wid*2048;
    #pragma unroll
    for(int r=0;r<16;++r){const int orow=crow(r,hi);
      #pragma unroll
      for(int d0=0;d0<2;++d0)stg[orow*64+d0*32+r32]=__builtin_bit_cast(unsigned short,(_Float16)(o[d0][r]*rli[r]));}
    asm volatile("s_waitcnt lgkmcnt(0)":::"memory");
    #pragma unroll
    for(int i=0;i<4;++i){const int row=i*8+(lane>>3),ch=lane&7; const u32x4 v=*(const u32x4*)(stg+row*64+ch*8); ATTN_STORE16(Ow+(long)row*DM+ch*8,v);} }
  asm volatile("s_waitcnt lgkmcnt(0)\n\ts_barrier":::"memory");
  #undef DMA_K
  #undef DMA_V
  #undef CMASK
  #undef START
  #undef RESC
  #undef ROT
}
constexpr int ATTN_LDS_BYTES=LDS_BYTES;
struct AttnTensors { const bf16* Q; const bf16* K; const bf16* V; bf16* O; const float* KMEAN; };
struct AttnUnit { int bh; int qb; };
struct StaticOrder {
  int vcu,G;
  __device__ __forceinline__ explicit StaticOrder(int grid,int block):vcu((grid%8==0)?(block%8)*(grid/8)+block/8:block),G(grid){}
  __device__ __forceinline__ bool next(int i,AttnUnit&u)const{
    if(G==256){ if(i>=2)return false; const int s=vcu&15; u.bh=vcu>>4; u.qb=(i==0)?s:31-s; return true; }
    const int idx=i*G+vcu; if(idx>=512)return false; u.bh=idx>>5; u.qb=31-(idx&31); return true; }
  __device__ __forceinline__ void a_ready(const AttnUnit&)const{}
  __device__ __forceinline__ void done(const AttnUnit&)const{}
};
template<class Sched,int THRL=8> __device__ __forceinline__ void attn_phase(char*lds,const AttnTensors&T,const Sched&S,const int tid_hw){
  AttnUnit u;
  for(int i=0;S.next(i,u);++i){ S.a_ready(u); attn_unit<THRL>(u.bh/NHEAD,u.bh%NHEAD,u.qb,T.Q,T.K,T.V,T.O,T.KMEAN,lds,tid_hw); S.done(u); }
}
#undef SBAR
#undef WAIT_BAR
}
struct Frame {
    LAS unsigned char* lds;
    volatile LAS unsigned* MISC;
    gu32* ctl;
    int tid, lane, wave, vcu, G;
};
struct Args { const void* in[20]; float* out; unsigned char* ws; int ph_lo, ph_hi; };

__device__ __forceinline__ float wave_sum(float v) {
#pragma unroll
    for (int o = 1; o < 64; o <<= 1) v += __shfl_xor(v, o);
    return v;
}

__device__ __forceinline__ int ropemap32(int p) { return (p < 16) ? (((p >> 2) & 1) * 8 + (p >> 3) * 4 + (p & 3)) : p; }
__device__ __forceinline__ int win_src(int r, float& scale) {
    scale = 1.0f;
    const int tile = r >> 8, w = r & 255;
    if (tile == 4) {
        if (w < 128) return 512 + w;
        if (w < 192) return 1168 + ropemap32(w - 128);
        if (w < 224) { const int p = w - 192; if (p < 16) return 640 + ropemap32(p); if (p < 24) return 1232 + (p - 16); return -1; }
        return -1;
    }
    if (tile == 5) {
        if (w >= 128) return -1;
        const int grp = w >> 5, p = w & 31, fq = p >> 3, n = (p >> 2) & 1, e = p & 3;
        scale = C2F; return (2 * grp + (fq >> 1)) * 64 + n * 8 + 4 * (fq & 1) + e;
    }
    if (tile < 12) {
        const int base = (tile < 8) ? 656 : (tile < 10) ? 1240 : 1752, t0 = (tile < 8) ? 6 : (tile < 10) ? 8 : 10;
        const int rr = r - t0 * 256, hd = rr >> 6, g = rr & 63;
        if (tile == 8 || tile == 9) scale = C2F;
        return base + hd * 64 + ((g < 32) ? ropemap32(g) : g);
    }
    if (tile < 14) return 2264 + (r - 12 * 256);
    if (tile < 18) return 2776 + (r - 14 * 256);
    return 3800 + (r - 18 * 256);
}
template <int MODE>
__device__ __forceinline__ void wt_item(const float* W, int Nsrc, int K, h16* WT, int row_base, LAS float* scr, int kb, int nb, int lane, const float* aux) {
    const int k0 = 64 * kb, r = row_base + nb * 32 + (lane & 31), half = lane >> 5;
    if constexpr (MODE <= 2) {
        int sc_ = r; float scale = 1.0f;
        if (MODE == 1) { const int t = r >> 8, w = r & 255; sc_ = (w < 128) ? (128 * t + w) : (DFF + 128 * t + (w - 128)); }
        if (MODE == 2) sc_ = win_src(r, scale);
        float wv_[32];
        const float* wp_ = W + (size_t)(k0 + half) * Nsrc + (sc_ >= 0 ? sc_ : 0);
#pragma unroll
        for (int i = 0; i < 32; ++i) wv_[i] = wp_[(size_t)(2 * i) * Nsrc];
#pragma unroll
        for (int i = 0; i < 32; ++i) scr[(2 * i + half) * 33 + (lane & 31)] = (sc_ >= 0) ? wv_[i] * scale : 0.0f;
    } else if constexpr (MODE == 3) {
        const int h = r >> 7, rr = r & 127; const float* uk = aux + rr * 384 + h * 48;
        float ukv[48];
#pragma unroll
        for (int n = 0; n < 48; ++n) ukv[n] = uk[n];
        for (int i = 0; i < 32; ++i) { const int kk = 2 * i + half; const float* wr_ = W + (size_t)(k0 + kk) * Nsrc + h * 64 + 16; float s = 0.f;
#pragma unroll
            for (int n = 0; n < 48; ++n) s += wr_[n] * ukv[n];
            scr[kk * 33 + (lane & 31)] = s * C2F; }
    } else {
        const int h = k0 >> 7; float bv[64];
#pragma unroll
        for (int d = 0; d < 64; ++d) bv[d] = W[(size_t)(h * 64 + d) * Nsrc + r];
        for (int i = 0; i < 32; ++i) { const int kk = 2 * i + half, rr = (k0 & 127) + kk; const float* uv = aux + rr * 512 + h * 64; float s = 0.f;
#pragma unroll
            for (int d = 0; d < 64; ++d) s += uv[d] * bv[d];
            scr[kk * 33 + (lane & 31)] = s; }
    }
    LDS_WAIT(); asm volatile("" ::: "memory");
    const int c = lane & 7;
#pragma unroll
    for (int j = 0; j < 4; ++j) { const int n = (lane >> 3) + 8 * j; const LAS float* s = scr + (8 * c) * 33 + n;
        v4u o; o.x = pkh(s[0 * 33], s[1 * 33]); o.y = pkh(s[2 * 33], s[3 * 33]); o.z = pkh(s[4 * 33], s[5 * 33]); o.w = pkh(s[6 * 33], s[7 * 33]);
        *(GAS v4u*)(WT + (size_t)(row_base + nb * 32 + n) * K + k0 + 8 * c) = o; }
    LDS_WAIT(); asm volatile("" ::: "memory");
}

__device__ __forceinline__ void rope_entry(int pos, int j, float& c, float& s) {
    const double invf[8] = {1.0, 0.19392274474868576, 0.03760603093086393, 0.007292664737217109, 0.001414213562373095, 0.0002742481756762073, 5.318295896944988e-05, 1.031338537721246e-05};
    double f = 1.0;
#pragma unroll
    for (int q = 0; q < 8; ++q) f = (q == j) ? invf[q] : f;
    const double ang = (double)pos * f;
    const double qd = __builtin_rint(ang * 0.6366197723675814);
    double r = __builtin_fma(-qd, 1.5707963267948966, ang); r = __builtin_fma(-qd, 6.123233995736766e-17, r);
    const double r2 = r * r;
    double sp = 1.0 / 6227020800.0; sp = sp * r2 - 1.0 / 39916800.0; sp = sp * r2 + 1.0 / 362880.0; sp = sp * r2 - 1.0 / 5040.0; sp = sp * r2 + 1.0 / 120.0; sp = sp * r2 - 1.0 / 6.0; sp = sp * r2 + 1.0;
    const double sn = r * sp;
    double cp = -1.0 / 87178291200.0; cp = cp * r2 + 1.0 / 479001600.0; cp = cp * r2 - 1.0 / 3628800.0; cp = cp * r2 + 1.0 / 40320.0; cp = cp * r2 - 1.0 / 720.0; cp = cp * r2 + 1.0 / 24.0; cp = cp * r2 - 0.5; cp = cp * r2 + 1.0;
    const int qi = ((int)qd) & 3;
    const double cc = (qi == 0) ? cp : (qi == 1) ? -sn : (qi == 2) ? -cp : sn;
    const double ss = (qi == 0) ? sn : (qi == 1) ? cp : (qi == 2) ? -sn : -cp;
    c = (float)cc; s = (float)ss;
}

__device__ __forceinline__ void p0_prologue(Frame& F, const void* a1, const void* a2, const void* a3, const void* a4, const void* a6, const void* a7, const void* a17, const void* a18, const void* a9, const void* a11, const void* a12, const void* a13, const void* a14, const void* a15, unsigned char* ws) {
    const float* ada_w = (const float*)a3; const float* ada_b = (const float*)a4; const float* cvec = (const float*)a1;
    {
        LAS float* red = (LAS float*)(F.lds + XS_OFF);
        float* MOD = (float*)(ws + WS_MOD);
        for (int it = F.vcu; it < NMODV / 64; it += F.G) {
            const int n = it * 64 + F.lane; float a0 = 0.f, a1 = 0.f;
            const int kbeg = F.wave * 128;
#pragma unroll 8
            for (int k = kbeg; k < kbeg + 128; ++k) { const float w = ada_w[(size_t)k * NMODV + n]; a0 += silu_f(cvec[k]) * w; a1 += silu_f(cvec[DM + k]) * w; }
            red[(F.wave * 2 + 0) * 64 + F.lane] = a0; red[(F.wave * 2 + 1) * 64 + F.lane] = a1;
            __syncthreads();
            if (F.wave < 2) { float s = ada_b[n];
#pragma unroll
                for (int w = 0; w < 8; ++w) s += red[(w * 2 + F.wave) * 64 + F.lane];
                MOD[(size_t)F.wave * NMODV + n] = s; }
            __syncthreads();
        }
    }
    {
        const int* pos = (const int*)a2; float* ROPE = (float*)(ws + WS_ROPE);
        for (int e = F.vcu * 512 + F.tid; e < MTOK * 8; e += F.G * 512) { const int m = e >> 3, j = e & 7; float c, s; rope_entry(pos[m], j, c, s); ROPE[(size_t)m * 16 + j] = c; ROPE[(size_t)m * 16 + 8 + j] = s; }
    }
    LAS float* scr = (LAS float*)(F.lds + RING_OFF + F.wave * 16384);
    const int gw = F.vcu * NWAVES + F.wave, NGW = F.G * NWAVES;
    const float* w1i = (const float*)a6; const float* w1o = (const float*)a7; const float* w2i = (const float*)a17; const float* w2o = (const float*)a18;
    const float* win = (const float*)a9; const float* wuk = (const float*)a11; const float* wuv = (const float*)a12;
    const float* wba = (const float*)a13; const float* wbb = (const float*)a14; const float* wo = (const float*)a15;
    constexpr int I_QL = 16 * 32, I_BA = 16 * 32, I_1A = 16 * 176, I_1B = 44 * 32, I_IN = 16 * 144, I_BB = 8 * 32, I_O = 16 * 32;
    constexpr int NITEMS = I_QL + I_BA + 2 * I_1A + 2 * I_1B + I_IN + I_BB + I_O;
    for (int it = gw; it < NITEMS; it += NGW) {
        int r = it;
        if (r < I_QL) { wt_item<3>(win, 4824, DM, (h16*)(ws + WS_WIN), 0, scr, r / 32, r % 32, F.lane, wuk); continue; } r -= I_QL;
        if (r < I_BA) { wt_item<4>(wba, DM, DM, (h16*)(ws + WS_WBA), 0, scr, r / 32, r % 32, F.lane, wuv); continue; } r -= I_BA;
        if (r < I_1A) { wt_item<1>(w1i, 2 * DFF, DM, (h16*)(ws + WS_W1A), 0, scr, r / 176, r % 176, F.lane, nullptr); continue; } r -= I_1A;
        if (r < I_1A) { wt_item<1>(w2i, 2 * DFF, DM, (h16*)(ws + WS_W2A), 0, scr, r / 176, r % 176, F.lane, nullptr); continue; } r -= I_1A;
        if (r < I_1B) { wt_item<0>(w1o, DM, DFF, (h16*)(ws + WS_W1B), 0, scr, r / 32, r % 32, F.lane, nullptr); continue; } r -= I_1B;
        if (r < I_1B) { wt_item<0>(w2o, DM, DFF, (h16*)(ws + WS_W2B), 0, scr, r / 32, r % 32, F.lane, nullptr); continue; } r -= I_1B;
        if (r < I_IN) { wt_item<2>(win, 4824, DM, (h16*)(ws + WS_WIN), 1024, scr, r / 144, r % 144, F.lane, nullptr); continue; } r -= I_IN;
        if (r < I_BB) { wt_item<0>(wbb, DM, 512, (h16*)(ws + WS_WBB), 0, scr, r / 32, r % 32, F.lane, nullptr); continue; } r -= I_BB;
        wt_item<0>(wo, DM, DM, (h16*)(ws + WS_WO), 0, scr, r / 32, r % 32, F.lane, nullptr);
    }
}

template <int MODE>
__device__ __forceinline__ void norm_rows(Frame& F, const float* src, const float* g, const float* sh, const float* sc, h16* dst16, float* dst32) {
    const int gw = F.vcu * NWAVES + F.wave, NGW = F.G * NWAVES;
    for (int m0 = gw * 8; m0 < MTOK; m0 += NGW * 8) {
        const int b = m0 / SEQ;
        f32x4 av[4], sv[4];
#pragma unroll
        for (int j = 0; j < 4; ++j) { const int c = 4 * F.lane + 256 * j; av[j] = *(const f32x4*)(g + c);
            if (MODE == 0) { av[j] = av[j] * (*(const f32x4*)(sc + (size_t)b * NMODV + c) + 1.0f); sv[j] = *(const f32x4*)(sh + (size_t)b * NMODV + c); } }
        for (int m = m0; m < m0 + 8; ++m) {
            const GAS f32x4* xr = (const GAS f32x4*)(src + (size_t)m * DM) + F.lane;
            f32x4 v[4]; float s = 0.f;
#pragma unroll
            for (int j = 0; j < 4; ++j) { v[j] = xr[64 * j]; s += (v[j].x * v[j].x + v[j].y * v[j].y) + (v[j].z * v[j].z + v[j].w * v[j].w); }
            const float rstd = 1.0f / sqrtf(wave_sum(s) * (1.0f / DM) + EPS_F);
            if (MODE == 0) {
                GAS v2u* o8 = (GAS v2u*)(dst16 + (size_t)m * DM) + F.lane;
#pragma unroll
                for (int j = 0; j < 4; ++j) { const f32x4 y = v[j] * rstd * av[j] + sv[j]; v2u w; w.x = pkh(y.x, y.y); w.y = pkh(y.z, y.w); o8[64 * j] = w; }
            } else {
                GAS f32x4* o = (GAS f32x4*)(dst32 + (size_t)m * DM) + F.lane;
#pragma unroll
                for (int j = 0; j < 4; ++j) o[64 * j] = v[j] * rstd * av[j];
            }
        }
    }
}
namespace dsa {
typedef _Float16 f16x8 __attribute__((ext_vector_type(8)));
typedef float f32x4 __attribute__((ext_vector_type(4)));
typedef short s16x4 __attribute__((ext_vector_type(4)));
typedef short s16x8 __attribute__((ext_vector_type(8)));
constexpr int CAP = 1024, TRIG = 768, KEEP = 256, SLACK = 320, NSL = CAP / 64, CTARGET = 480;
constexpr int L_KEY = 0, L_IDX = 65536, L_GBUF = 0, ROWB = 336, GBUF_W = 32 * ROWB + 2048, L_CNT = 118784, L_SEL = 122880;
static_assert(8 * GBUF_W <= L_CNT && L_IDX + 16 * CAP * 2 <= L_CNT, "dsa lds map");
__device__ __forceinline__ unsigned ordkey(float f) { const unsigned u = __builtin_bit_cast(unsigned, f); return (u & 0x80000000u) ? ~u : (u | 0x80000000u); }

__device__ __forceinline__ unsigned wave_umax(unsigned v) {
#pragma unroll
    for (int o = 1; o < 64; o <<= 1) { const unsigned w = (unsigned)__shfl_xor((int)v, o); v = v > w ? v : w; }
    return v;
}
__device__ __forceinline__ unsigned wave_umin(unsigned v) {
#pragma unroll
    for (int o = 1; o < 64; o <<= 1) { const unsigned w = (unsigned)__shfl_xor((int)v, o); v = v < w ? v : w; }
    return v;
}
#define DSA_COUNT(c, pred) do { c = 0; _Pragma("unroll") for (int i = 0; i < 8; ++i) c += __popcll(__ballot(pred)); if (ni > 8) { _Pragma("unroll") for (int i = 8; i < NSL; ++i) c += __popcll(__ballot(pred)); } } while (0)
template <bool EXACT>
__device__ __forceinline__ void wave_select(LAS unsigned* keyp, LAS unsigned short* idxp, int n, LAS unsigned* cntp, LAS unsigned* thrp, LAS unsigned short* selp, LAS unsigned* selnp, int lane) {
    unsigned kh[NSL], kl[NSL]; const int ni = (n + 63) >> 6;
#pragma unroll
    for (int i = 0; i < NSL; ++i) { const int e = i * 64 + lane; const bool v = e < n; kh[i] = v ? keyp[e] : 0u; kl[i] = v ? (8191u - (unsigned)idxp[e]) : 0u; }
    unsigned Th = 0u, Tl = 0u;
    if (n > KEEP) {
        unsigned mx = 0u, mn = 0xffffffffu;
#pragma unroll
        for (int i = 0; i < NSL; ++i) { mx = kh[i] > mx ? kh[i] : mx; const unsigned t = (i * 64 + lane < n) ? kh[i] : 0xffffffffu; mn = t < mn ? t : mn; }
        mx = (unsigned)__builtin_amdgcn_readfirstlane((int)wave_umax(mx)); mn = (unsigned)__builtin_amdgcn_readfirstlane((int)wave_umin(mn));
        const unsigned df = mx ^ mn; int cge = n; Th = mn;
        if (df != 0u) {
            const int hb = 31 - __builtin_clz(df); Th = mx & ~((2u << hb) - 1u);
            for (int bit = hb; bit >= 0; --bit) {
                const unsigned cand = Th | (1u << bit); int c; DSA_COUNT(c, kh[i] >= cand);
                if (c >= KEEP) { Th = cand; cge = c; if (c == KEEP || (!EXACT && c <= SLACK)) break; }
            }
        }
        if (cge > (EXACT ? KEEP : SLACK)) {
            int gt; DSA_COUNT(gt, kh[i] > Th);
            const int R = KEEP - gt;
            for (int bit = 12; bit >= 0; --bit) {
                const unsigned cand = Tl | (1u << bit); int c; DSA_COUNT(c, kh[i] == Th && kl[i] >= cand);
                if (c >= R) Tl = cand;
            }
        }
    }
    int base = 0; const unsigned long long ltmask = (1ull << lane) - 1ull;
#pragma unroll
    for (int i = 0; i < NSL; ++i) {
        const bool keep = (n > KEEP) ? (kh[i] > Th || (kh[i] == Th && kl[i] >= Tl)) : (i * 64 + lane < n);
        const unsigned long long m = __ballot(keep); const int pos = base + __popcll(m & ltmask);
        if (keep) { if (EXACT) selp[pos] = (unsigned short)(8191u - kl[i]); else { keyp[pos] = kh[i]; idxp[pos] = (unsigned short)(8191u - kl[i]); } }
        base += __popcll(m);
    }
    if (lane == 0) { if (EXACT) selnp[0] = (unsigned)base; else { cntp[0] = (unsigned)base; thrp[0] = Th; } }
}

__device__ __forceinline__ unsigned wave_kth(LAS unsigned* keyp, int m, int k, int lane) {
    unsigned kh[NSL]; const int ni = (m + 63) >> 6;
    unsigned mx = 0u, mn = 0xffffffffu;
#pragma unroll
    for (int i = 0; i < NSL; ++i) { const int e = i * 64 + lane; const bool v = e < m; kh[i] = v ? keyp[e] : 0u; mx = kh[i] > mx ? kh[i] : mx; const unsigned t = v ? kh[i] : 0xffffffffu; mn = t < mn ? t : mn; }
    mx = (unsigned)__builtin_amdgcn_readfirstlane((int)wave_umax(mx)); mn = (unsigned)__builtin_amdgcn_readfirstlane((int)wave_umin(mn));
    const unsigned df = mx ^ mn; unsigned Th = mn; const int khi = k + (k >> 3);
    if (df != 0u) {
        const int hb = 31 - __builtin_clz(df); Th = mx & ~((2u << hb) - 1u);
        for (int bit = hb; bit >= 0; --bit) {
            const unsigned cand = Th | (1u << bit); int c; DSA_COUNT(c, kh[i] >= cand);
            if (c >= k) { Th = cand; if (c <= khi) break; }
        }
    }
    return Th;
}

__device__ __forceinline__ void dsa_unit(unsigned char* ws, LAS unsigned char* lds, int b, int qt, int tid_) {
    int tid = tid_; asm volatile("" : "+v"(tid));
    const int lane = tid & 63, wave = __builtin_amdgcn_readfirstlane(tid >> 6), g = lane >> 4, c16 = lane & 15;
    const int t0 = 16 * qt; const size_t m0 = (size_t)b * SEQ + t0;
    LAS unsigned* KEYS = (LAS unsigned*)(lds + L_KEY); LAS unsigned short* IDXS = (LAS unsigned short*)(lds + L_IDX);
    LAS unsigned* CNT = (LAS unsigned*)(lds + L_CNT); LAS unsigned* THR = CNT + 16; LAS unsigned* SELN = CNT + 32;
    LAS unsigned short* SEL = (LAS unsigned short*)(lds + L_SEL);
    const GAS h16* QIDX = (const GAS h16*)(ws + WS_QIDX); const GAS h16* KIDX = (const GAS h16*)(ws + WS_KIDX); const GAS float* WIDX = (const GAS float*)(ws + WS_WIDX);
#if PROBE == 2
    for (int rep_ = 0; rep_ < 2; ++rep_) {
    __syncthreads();
#else
    {
#endif
    if (tid < 16) { CNT[tid] = 0u; THR[tid] = 0u; }
    __syncthreads();
    f16x8 qf[8][2]; float wv[8];
#pragma unroll
    for (int h = 0; h < 8; ++h) {
#pragma unroll
        for (int ks = 0; ks < 2; ++ks) qf[h][ks] = *(const GAS f16x8*)(QIDX + (m0 + c16) * 512 + h * 64 + ks * 32 + 8 * g);
        wv[h] = WIDX[(m0 + c16) * 8 + h]; }
    const int tq = t0 + c16;
    const GAS h16* KB_ = KIDX + (size_t)b * SEQ * 64;
#define DSA_SCORE(dst, a0, a1) do { f32x4 s_ = {0.f, 0.f, 0.f, 0.f}; \
        _Pragma("unroll") for (int h = 0; h < 8; ++h) { f32x4 acc_ = {0.f, 0.f, 0.f, 0.f}; \
            acc_ = __builtin_amdgcn_mfma_f32_16x16x32_f16(a0, qf[h][0], acc_, 0, 0, 0); acc_ = __builtin_amdgcn_mfma_f32_16x16x32_f16(a1, qf[h][1], acc_, 0, 0, 0); \
            _Pragma("unroll") for (int r = 0; r < 4; ++r) s_[r] += wv[h] * fmaxf(acc_[r], 0.f); } \
        dst = s_; } while (0)
#define DSA_SCORE_F(dst, a0, a1) do { f32x4 s_ = {0.f, 0.f, 0.f, 0.f}, ac_[8]; \
        _Pragma("unroll") for (int h = 0; h < 8; ++h) { ac_[h] = (f32x4){0.f, 0.f, 0.f, 0.f}; ac_[h] = __builtin_amdgcn_mfma_f32_16x16x32_f16(a0, qf[h][0], ac_[h], 0, 0, 0); } \
        _Pragma("unroll") for (int h = 0; h < 8; ++h) ac_[h] = __builtin_amdgcn_mfma_f32_16x16x32_f16(a1, qf[h][1], ac_[h], 0, 0, 0); \
        s_ = __builtin_amdgcn_mfma_f32_16x16x32_f16(a0, qch[0], s_, 0, 0, 0); s_ = __builtin_amdgcn_mfma_f32_16x16x32_f16(a1, qch[1], s_, 0, 0, 0); \
        s_ = __builtin_amdgcn_mfma_f32_16x16x32_f16(a0, qcl[0], s_, 0, 0, 0); s_ = __builtin_amdgcn_mfma_f32_16x16x32_f16(a1, qcl[1], s_, 0, 0, 0); \
        _Pragma("unroll") for (int h = 0; h < 8; ++h) { _Pragma("unroll") for (int r = 0; r < 4; ++r) s_[r] = __builtin_fmaf(wv[h], __builtin_fabsf(ac_[h][r]), s_[r]); } \
        dst = s_; } while (0)
    f16x8 qch[2], qcl[2];
#pragma unroll
    for (int ks = 0; ks < 2; ++ks)
#pragma unroll
        for (int j = 0; j < 8; ++j) { float v = 0.f;
#pragma unroll
            for (int h = 0; h < 8; ++h) v += wv[h] * (float)qf[h][ks][j];
            const _Float16 hi_ = (_Float16)v; qch[ks][j] = hi_; qcl[ks][j] = (_Float16)(v - (float)hi_); }
    const int nmax = t0 + 16;
    bool fast = true;
    if (nmax > CAP) {
        const int st = (nmax <= 2048) ? 2 : (nmax <= 4096) ? 4 : 8, mu = t0 / st + 1, ntile = (mu + 15) >> 4;
        for (int tile = wave; tile < ntile; tile += 8) {
            const int i0 = tile * 16; int si = i0 + c16; si = si < mu ? si : mu - 1;
            const GAS h16* kr = KB_ + (size_t)(si * st) * 64 + 8 * g;
            const f16x8 a0 = *(const GAS f16x8*)kr, a1 = *(const GAS f16x8*)(kr + 32);
            f32x4 s; DSA_SCORE_F(s, a0, a1);
#pragma unroll
            for (int r = 0; r < 4; ++r) { const int i = i0 + 4 * g + r; if (i < mu) KEYS[c16 * CAP + i] = ordkey(s[r]); }
        }
        __syncthreads();
        const int ks_ = CTARGET / st;
#pragma unroll
        for (int qi = 0; qi < 2; ++qi) { const int q = 2 * wave + qi; const unsigned th = wave_kth(KEYS + q * CAP, mu, ks_, lane); if (lane == 0) THR[q] = th; }
        __syncthreads();
    }
    {
        const bool big = nmax > CAP;
        const unsigned thk = THR[c16]; const float thrf = __builtin_bit_cast(float, (thk & 0x80000000u) ? (thk ^ 0x80000000u) : ~thk);
        const int nsteps = (nmax + 255) >> 8;
        f16x8 ka[2][2];
#define DSA_KLOAD(step_) do { _Pragma("unroll") for (int kt = 0; kt < 2; ++kt) { int kb_ = (step_) * 256 + wave * 32 + 16 * kt + c16; kb_ = kb_ < SEQ ? kb_ : SEQ - 1; \
            const GAS h16* kr_ = KB_ + (size_t)kb_ * 64 + 8 * g; ka[kt][0] = *(const GAS f16x8*)kr_; ka[kt][1] = *(const GAS f16x8*)(kr_ + 32); } } while (0)
#if PROBE == 11
        for (int rs_ = 0; rs_ < 2; ++rs_) { if (rs_) { if (tid < 16) CNT[tid] = 0u; __syncthreads(); }
#else
        {
#endif
        DSA_KLOAD(0);
        for (int step = 0; step < nsteps; ++step) {
            const int kb0 = step * 256 + wave * 32;
            const f16x8 c00 = ka[0][0], c01 = ka[0][1], c10 = ka[1][0], c11 = ka[1][1];
            if (step + 1 < nsteps) DSA_KLOAD(step + 1);
#pragma unroll
            for (int kt = 0; kt < 2; ++kt) {
                const int kb = kb0 + 16 * kt;
                if (kb <= t0 + 15) {
                    f32x4 s;
                    if (big) { if (kt == 0) DSA_SCORE_F(s, c00, c01); else DSA_SCORE_F(s, c10, c11); }
                    else { if (kt == 0) DSA_SCORE(s, c00, c01); else DSA_SCORE(s, c10, c11); }
                    bool f[4]; bool anyf;
                    if (big && kb + 15 <= t0) {
#pragma unroll
                        for (int r = 0; r < 4; ++r) f[r] = s[r] > thrf;
                        anyf = __builtin_amdgcn_readfirstlane((int)(__ballot(f[0] || f[1] || f[2] || f[3]) != 0ull)) != 0;
                    } else {
#pragma unroll
                        for (int r = 0; r < 4; ++r) f[r] = (kb + 4 * g + r <= tq) && (!big || s[r] > thrf);
                        anyf = true;
                    }
                    if (anyf) {
                        const unsigned nf = (f[0] ? 1u : 0u) + (f[1] ? 1u : 0u) + (f[2] ? 1u : 0u) + (f[3] ? 1u : 0u);
                        if (nf) {
                            unsigned pos = __hip_atomic_fetch_add(CNT + c16, nf, __ATOMIC_RELAXED, __HIP_MEMORY_SCOPE_WORKGROUP);
#pragma unroll
                            for (int r = 0; r < 4; ++r) if (f[r]) { if (pos < (unsigned)CAP) { KEYS[c16 * CAP + pos] = ordkey(s[r]); IDXS[c16 * CAP + pos] = (unsigned short)(kb + 4 * g + r); } ++pos; }
                        }
                    }
                }
            }
        }
        __syncthreads();
        }
#pragma unroll
        for (int q = 0; q < 16; ++q) { const unsigned n = CNT[q]; const unsigned need = (unsigned)((t0 + q + 1) < KEEP ? (t0 + q + 1) : KEEP); fast &= (n >= need) && (n <= (unsigned)CAP); }
    }
    fast = __builtin_amdgcn_readfirstlane((int)fast) != 0;
#if PROBE == 13
    fast = true;
#endif
    if (!fast) {
        __syncthreads();
        if (tid < 16) { CNT[tid] = 0u; THR[tid] = 0u; }
        const int nsteps = (nmax + 255) >> 8;
        for (int step = 0; step < nsteps; ++step) {
            const int kb0 = step * 256 + wave * 32;
            f32x4 sc[2];
#pragma unroll
            for (int kt = 0; kt < 2; ++kt) {
                const int kb = kb0 + 16 * kt; sc[kt] = (f32x4){0.f, 0.f, 0.f, 0.f};
                if (kb <= t0 + 15) {
                    const GAS h16* kr = KB_ + (size_t)(kb + c16) * 64 + 8 * g;
                    const f16x8 a0 = *(const GAS f16x8*)kr, a1 = *(const GAS f16x8*)(kr + 32);
                    DSA_SCORE(sc[kt], a0, a1);
                }
            }
            __syncthreads();
            const unsigned thr = THR[c16];
#pragma unroll
            for (int kt = 0; kt < 2; ++kt)
#pragma unroll
                for (int r = 0; r < 4; ++r) {
                    const int s = kb0 + 16 * kt + 4 * g + r; const unsigned key = ordkey(sc[kt][r]);
                    if (s <= tq && key > thr) { const unsigned pos = __hip_atomic_fetch_add(CNT + c16, 1u, __ATOMIC_RELAXED, __HIP_MEMORY_SCOPE_WORKGROUP);
                        if (pos < (unsigned)CAP) { KEYS[c16 * CAP + pos] = key; IDXS[c16 * CAP + pos] = (unsigned short)s; } }
                }
            __syncthreads();
            if (step + 1 < nsteps) {
                bool any = false;
#pragma unroll
                for (int q = 0; q < 16; ++q) any |= CNT[q] > (unsigned)TRIG;
                if (any) {
#pragma unroll
                    for (int qi = 0; qi < 2; ++qi) { const int q = 2 * wave + qi; const int n = __builtin_amdgcn_readfirstlane((int)CNT[q]);
                        if (n > 384) wave_select<false>(KEYS + q * CAP, IDXS + q * CAP, n, CNT + q, THR + q, nullptr, nullptr, lane); }
                }
            }
        }
    }
#undef DSA_SCORE
#undef DSA_SCORE_F
#undef DSA_KLOAD
    }
#if PROBE == 8
    for (int rep8 = 0; rep8 < 2; ++rep8)
#endif
#pragma unroll
    for (int qi = 0; qi < 2; ++qi) { const int q = 2 * wave + qi; int n = __builtin_amdgcn_readfirstlane((int)CNT[q]); n = n > CAP ? CAP : n;
        wave_select<true>(KEYS + q * CAP, IDXS + q * CAP, n, nullptr, nullptr, SEL + q * 256, SELN + q, lane); }
    __syncthreads();
    const GAS h16* QLAT = (const GAS h16*)(ws + WS_QLAT); const GAS h16* QR = (const GAS h16*)(ws + WS_QR); const GAS unsigned char* CK = (const GAS unsigned char*)(ws + WS_CKVR) + (size_t)b * SEQ * 320;
    LAS unsigned char* gb = lds + L_GBUF + wave * GBUF_W;
    { const v4u z = {0u, 0u, 0u, 0u}; *(LAS v4u*)(gb + (lane >> 1) * ROWB + 288 + (lane & 1) * 16) = z; }
#if PROBE == 3
    for (int qq = 0; qq < 4; ++qq) { const int qi = qq & 1; const bool dost = qq >= 2;
#else
    for (int qi = 0; qi < 2; ++qi) { const bool dost = true;
#endif
        const int q = 2 * wave + qi; const size_t m = m0 + q; const int nsel = __builtin_amdgcn_readfirstlane((int)SELN[q]); const int nch = (nsel + 31) >> 5;
        LAS unsigned short* selq = SEL + q * 256;
        int lane_o = lane; asm volatile("" : "+v"(lane_o));
        f16x8 bq[5];
        { const f16x8 z = {0, 0, 0, 0, 0, 0, 0, 0};
#pragma unroll
          for (int ks = 0; ks < 4; ++ks) bq[ks] = (c16 < 8) ? *(const GAS f16x8*)(QLAT + m * 1024 + c16 * 128 + ks * 32 + 8 * g) : z;
          bq[4] = (c16 < 8 && g < 2) ? *(const GAS f16x8*)(QR + m * 128 + c16 * 16 + 8 * g) : z; }
        f32x4 O[8];
#pragma unroll
        for (int rt = 0; rt < 8; ++rt) O[rt] = (f32x4){0.f, 0.f, 0.f, 0.f};
        float mrun = -INFINITY, lrun = 0.f;
        v4u pre[9];
        const int gl = lane_o >> 4, gp = lane_o & 15;
#define DSA_GATHER(cc) do { \
            _Pragma("unroll") for (int i = 0; i < 8; ++i) { const int slot = (cc) * 32 + 4 * i + gl; const unsigned idx = (slot < nsel) ? (unsigned)selq[slot] : 0u; \
                pre[i] = *(const GAS v4u*)(CK + (size_t)idx * 320 + gp * 16); } \
            { const int slot = (cc) * 32 + (lane_o >> 1); const unsigned idx = (slot < nsel) ? (unsigned)selq[slot] : 0u; pre[8] = *(const GAS v4u*)(CK + (size_t)idx * 320 + 256 + (lane_o & 1) * 16); } } while (0)
        DSA_GATHER(0);
        for (int c = 0; c < nch; ++c) {
#pragma unroll
            for (int i = 0; i < 8; ++i) *(LAS v4u*)(gb + (4 * i + gl) * ROWB + gp * 16) = pre[i];
            *(LAS v4u*)(gb + (lane_o >> 1) * ROWB + 256 + (lane_o & 1) * 16) = pre[8];
            if (c + 1 < nch) DSA_GATHER(c + 1);
            f32x4 st[2];
#pragma unroll
            for (int kt = 0; kt < 2; ++kt) { f32x4 acc = {0.f, 0.f, 0.f, 0.f};
#pragma unroll
                for (int ks = 0; ks < 5; ++ks) { const f16x8 a = *(const LAS f16x8*)(gb + (kt * 16 + c16) * ROWB + ks * 64 + g * 16); acc = __builtin_amdgcn_mfma_f32_16x16x32_f16(a, bq[ks], acc, 0, 0, 0); }
                st[kt] = acc; }
            float cm = -INFINITY;
#pragma unroll
            for (int kt = 0; kt < 2; ++kt)
#pragma unroll
                for (int r = 0; r < 4; ++r) { const int slot = c * 32 + kt * 16 + 4 * g + r; if (slot >= nsel) st[kt][r] = -INFINITY; cm = fmaxf(cm, st[kt][r]); }
            cm = fmaxf(cm, __shfl_xor(cm, 16)); cm = fmaxf(cm, __shfl_xor(cm, 32));
            const float mnew = fmaxf(mrun, cm); const float alpha = __builtin_amdgcn_exp2f(mrun - mnew); mrun = mnew;
            float ps = 0.f; float p[2][4];
#pragma unroll
            for (int kt = 0; kt < 2; ++kt)
#pragma unroll
                for (int r = 0; r < 4; ++r) { p[kt][r] = __builtin_amdgcn_exp2f(st[kt][r] - mnew); ps += p[kt][r]; }
            lrun = lrun * alpha + ps;
            float ar[4];
#pragma unroll
            for (int r = 0; r < 4; ++r) ar[r] = __shfl(alpha, 4 * g + r);
#pragma unroll
            for (int rt = 0; rt < 8; ++rt)
#pragma unroll
                for (int r = 0; r < 4; ++r) O[rt][r] *= ar[r];
            v4u paw; paw.x = pkh(p[0][0], p[0][1]); paw.y = pkh(p[0][2], p[0][3]); paw.z = pkh(p[1][0], p[1][1]); paw.w = pkh(p[1][2], p[1][3]);
            const f16x8 pa = __builtin_bit_cast(f16x8, paw);
            LAS unsigned char* tb = gb + (4 * g + (c16 >> 2)) * ROWB + (c16 & 3) * 8;
#pragma unroll
            for (int rt = 0; rt < 8; ++rt) {
                const s16x4 lo = __builtin_bit_cast(s16x4, __builtin_amdgcn_ds_read_tr16_b64_v4i16((LAS s16x4*)(tb + rt * 32)));
                const s16x4 hi = __builtin_bit_cast(s16x4, __builtin_amdgcn_ds_read_tr16_b64_v4i16((LAS s16x4*)(tb + 16 * ROWB + rt * 32)));
                const f16x8 bv = __builtin_bit_cast(f16x8, (s16x8){lo[0], lo[1], lo[2], lo[3], hi[0], hi[1], hi[2], hi[3]});
                O[rt] = __builtin_amdgcn_mfma_f32_16x16x32_f16(pa, bv, O[rt], 0, 0, 0);
            }
        }
        lrun += __shfl_xor(lrun, 16); lrun += __shfl_xor(lrun, 32);
        const float inv = 1.0f / lrun; float ir[4];
#pragma unroll
        for (int r = 0; r < 4; ++r) ir[r] = __shfl(inv, 4 * g + r);
        LAS unsigned short* ob = (LAS unsigned short*)(gb + 32 * ROWB);
        if (g < 2) {
#pragma unroll
            for (int rt = 0; rt < 8; ++rt)
#pragma unroll
                for (int r = 0; r < 4; ++r) ob[(4 * g + r) * 128 + rt * 16 + c16] = __builtin_bit_cast(unsigned short, (_Float16)(O[rt][r] * ir[r]));
        }
        asm volatile("s_waitcnt lgkmcnt(0)" ::: "memory");
        GAS h16* OL = (GAS h16*)(ws + WS_QLAT) + m * 1024;
        if (dost)
#pragma unroll
        for (int i = 0; i < 2; ++i) { const int e = i * 64 + lane; *(GAS v4u*)(OL + e * 8) = *(const LAS v4u*)(ob + e * 8); }
        asm volatile("s_waitcnt lgkmcnt(0)" ::: "memory");
#undef DSA_GATHER
    }
    __syncthreads();
}

__device__ __forceinline__ void dsa_phase(Frame& F, unsigned char* ws) {
    const bool bal = F.G == 256; const int nu = bal ? 4 : (1024 + F.G - 1) / F.G;
    for (int i = 0; i < nu; ++i) {
        int b, qt;
        if (bal) { const int c = F.vcu & 127; b = F.vcu >> 7; qt = (i == 0) ? c : (i == 1) ? 255 - c : (i == 2) ? 256 + c : 511 - c; }
        else { const int u = F.vcu + i * F.G; if (u >= 1024) break; b = u >> 9; qt = 511 - (u & 511); }
        dsa_unit(ws, F.lds, b, qt, F.tid);
    }
}
}
using dsa::dsa_phase;
#ifndef MK_MIXER
#define MK_MIXER 1
#endif
#ifndef MK_DSA
#define MK_DSA 1
#endif
__global__ void __launch_bounds__(NWAVES * 64, 2) mega_fwd(Args args) {
    extern __shared__ __attribute__((aligned(16))) unsigned char lds[];
    Frame F;
    F.lds = (LAS unsigned char*)lds;
    F.MISC = (volatile LAS unsigned*)(F.lds + MISC_OFF);
    F.wave = __builtin_amdgcn_readfirstlane((int)threadIdx.x >> 6);
#define REFRESH() do { F.lane = hw_lane(); F.tid = F.wave * 64 + F.lane; } while (0)
    REFRESH();
    F.G = gridDim.x; { const int bx = blockIdx.x; F.vcu = (F.G % 8 == 0) ? (bx % 8) * (F.G / 8) + bx / 8 : bx; }
    const unsigned char __attribute__((address_space(4)))* kbase = (const unsigned char __attribute__((address_space(4)))*)__builtin_amdgcn_kernarg_segment_ptr();
#define KARG(i) ({ const unsigned char __attribute__((address_space(4)))* kp_ = kbase; asm volatile("" : "+s"(kp_)); *(const void* const __attribute__((address_space(4)))*)(kp_ + 8 * (i)); })
    unsigned char* ws = (unsigned char*)KARG(21);
    F.ctl = (gu32*)(ws + WS_CTL);
    for (int u = F.tid; u < 1024 / 4; u += NWAVES * 64) ((LAS unsigned*)(F.lds + LDSCTL_OFF))[u] = 0u;
    __syncthreads();
    XcdBarrier bar; bar.bar = (unsigned*)(F.ctl + CW_BAR); bar.x = 0; bar.st = nullptr;
    if (!MK_SPLIT) bar = xcd_barrier_post((unsigned*)(F.ctl + CW_BAR), F.MISC + 8, F.tid);
#define GRID_BAR() do { if (MK_SPLIT) { if (F.tid == 0) __hip_atomic_store(F.ctl + CW_TMO, 0xBADBA0u, RLX_AGENT); } else { REFRESH(); xcd_barrier(bar, F.tid); } } while (0)
    const int lo = args.ph_lo, hi = args.ph_hi;
#define WS_NOW ((unsigned char*)KARG(21))
#define IN(k) (lo <= (k) && (k) < hi)
#define BOTH(k) (IN(k) && IN((k) + 1))
#define XIN ((const float*)KARG(0))
#define OUTP ((float*)KARG(20))
    const float* MOD = (const float*)(ws + WS_MOD);
    h16* XN = (h16*)(ws + WS_XN); h16* HB = (h16*)(ws + WS_H);
    const int bx = (int)blockIdx.x;

    if (IN(0)) { REFRESH(); p0_prologue(F, (const void*)KARG(1), (const void*)KARG(2), (const void*)KARG(3), (const void*)KARG(4), (const void*)KARG(6), (const void*)KARG(7), (const void*)KARG(17), (const void*)KARG(18), (const void*)KARG(9), (const void*)KARG(11), (const void*)KARG(12), (const void*)KARG(13), (const void*)KARG(14), (const void*)KARG(15), ws);
#if PROBE == 9
        p0_prologue(F, (const void*)KARG(1), (const void*)KARG(2), (const void*)KARG(3), (const void*)KARG(4), (const void*)KARG(6), (const void*)KARG(7), (const void*)KARG(17), (const void*)KARG(18), (const void*)KARG(9), (const void*)KARG(11), (const void*)KARG(12), (const void*)KARG(13), (const void*)KARG(14), (const void*)KARG(15), ws);
#endif
#if PROBE == 10
        GRID_BAR(); GRID_BAR(); GRID_BAR(); GRID_BAR();
#endif
        if (BOTH(0)) GRID_BAR(); }
    if (IN(1)) { REFRESH(); norm_rows<0>(F, XIN, (const float*)KARG(5), MOD + 0 * DM, MOD + 1 * DM, XN, nullptr); if (BOTH(1)) GRID_BAR(); }
    if (IN(2)) { REFRESH();
        pg8::Gemm g{XN, (const h16*)(ws + WS_W1A), MTOK, 2 * DFF, DM}; pg8::StaticOrder S; S.init(MTOK, 2 * DFF, F.G, bx);
        EpiSwiglu E{HB};
        pg8::gemm_phase<EpiSwiglu, pg8::StaticOrder, true, true>(F.lds + RING_OFF, g, S, E, F.tid);
#if PROBE == 1
        pg8::gemm_phase<EpiSwiglu, pg8::StaticOrder, true, true>(F.lds + RING_OFF, g, S, E, F.tid);
#endif
        if (BOTH(2)) GRID_BAR();
    }
    if (IN(3)) { REFRESH();
        pg8::Gemm g{HB, (const h16*)(ws + WS_W1B), MTOK, DM, DFF}; pg8::StaticOrder S; S.init(MTOK, DM, F.G, bx);
        EpiResid E{XIN, OUTP, MOD + 2 * DM, 0.5f};
        pg8::gemm_phase<EpiResid, pg8::StaticOrder, true, true>(F.lds + RING_OFF, g, S, E, F.tid);
#if PROBE == 7
        pg8::gemm_phase<EpiResid, pg8::StaticOrder, true, true>(F.lds + RING_OFF, g, S, E, F.tid);
#endif
        if (BOTH(3)) GRID_BAR();
    }
    if (IN(4)) { REFRESH(); norm_rows<0>(F, OUTP, (const float*)KARG(8), MOD + 3 * DM, MOD + 4 * DM, XN, nullptr);
#if PROBE == 6
        norm_rows<0>(F, OUTP, (const float*)KARG(8), MOD + 3 * DM, MOD + 4 * DM, XN, nullptr);
#endif
 if (BOTH(4)) GRID_BAR(); }
#if MK_MIXER
    if (IN(5)) { REFRESH();
        pg8::Gemm g{XN, (const h16*)(ws + WS_WIN), MTOK, NPROJ, DM}; pg8::StaticOrder S; S.init(MTOK, NPROJ, F.G, bx);
        EpiProj E{ws, (const float*)KARG(10), (LAS float*)(F.lds + XS_OFF), true};
#if PROBE == 4
        { EpiProj E0{ws, (const float*)KARG(10), (LAS float*)(F.lds + XS_OFF), false}; pg8::gemm_phase<EpiProj, pg8::StaticOrder, true, true>(F.lds + RING_OFF, g, S, E0, F.tid); }
#endif
        pg8::gemm_phase<EpiProj, pg8::StaticOrder, true, true>(F.lds + RING_OFF, g, S, E, F.tid);
        if (BOTH(5)) GRID_BAR();
    }
    if (IN(6)) { REFRESH();
#if MK_DSA
        dsa_phase(F, ws);
        REFRESH();
#endif
        const moba_body::AttnTensors AT{(const moba_body::bf16*)(ws + WS_QB), (const moba_body::bf16*)(ws + WS_KB), (const moba_body::bf16*)(ws + WS_VB), (moba_body::bf16*)(ws + WS_QB), (const float*)(ws + WS_KMEAN)};
        const moba_body::StaticOrder S((int)F.G, bx);
#if PROBE == 5
        { const moba_body::AttnTensors AT0{(const moba_body::bf16*)(ws + WS_QB), (const moba_body::bf16*)(ws + WS_KB), (const moba_body::bf16*)(ws + WS_VB), (moba_body::bf16*)(ws + WS_XN), (const float*)(ws + WS_KMEAN)};
          moba_body::attn_phase<moba_body::StaticOrder>((char*)lds + RING_OFF, AT0, S, F.tid); }
#endif
        moba_body::attn_phase<moba_body::StaticOrder>((char*)lds + RING_OFF, AT, S, F.tid);
        if (BOTH(6)) GRID_BAR();
    }
    if (IN(7)) { REFRESH();
        h16* Y = (h16*)(ws + WS_Y);
#if MK_DSA
        { pg8::Gemm g{(const h16*)(ws + WS_QLAT), (const h16*)(ws + WS_WBA), MTOK, DM, DM}; pg8::StaticOrder S; S.init(MTOK, DM, F.G, bx);
          EpiBranch<false> E{(const h16*)(ws + WS_GA), Y};
          pg8::gemm_phase<EpiBranch<false>, pg8::StaticOrder, true, true>(F.lds + RING_OFF, g, S, E, F.tid); }
        { pg8::Gemm g{(const h16*)(ws + WS_QB), (const h16*)(ws + WS_WBB), MTOK, DM, 512}; pg8::StaticOrder S; S.init(MTOK, DM, F.G, bx);
          EpiBranch<true> E{(const h16*)(ws + WS_GB), Y};
          pg8::gemm_phase<EpiBranch<true>, pg8::StaticOrder, true, true>(F.lds + RING_OFF, g, S, E, F.tid); }
#else
        { pg8::Gemm g{(const h16*)(ws + WS_QB), (const h16*)(ws + WS_WBB), MTOK, DM, 512}; pg8::StaticOrder S; S.init(MTOK, DM, F.G, bx);
          EpiBranch<false> E{(const h16*)(ws + WS_GB), Y};
          pg8::gemm_phase<EpiBranch<false>, pg8::StaticOrder, true, true>(F.lds + RING_OFF, g, S, E, F.tid); }
#endif
        if (BOTH(7)) GRID_BAR();
    }
    if (IN(8)) { REFRESH();
        pg8::Gemm g{(const h16*)(ws + WS_Y), (const h16*)(ws + WS_WO), MTOK, DM, DM}; pg8::StaticOrder S; S.init(MTOK, DM, F.G, bx);
        EpiResid E{OUTP, OUTP, MOD + 5 * DM, 1.0f};
        pg8::gemm_phase<EpiResid, pg8::StaticOrder, true, true>(F.lds + RING_OFF, g, S, E, F.tid);
        if (BOTH(8)) GRID_BAR();
    }
#else
    if (IN(5)) { REFRESH(); if (BOTH(5)) GRID_BAR(); }
    if (IN(6)) { REFRESH(); if (BOTH(6)) GRID_BAR(); }
    if (IN(7)) { REFRESH(); if (BOTH(7)) GRID_BAR(); }
    if (IN(8)) { REFRESH(); if (BOTH(8)) GRID_BAR(); }
#endif
    if (IN(9)) { REFRESH(); norm_rows<0>(F, OUTP, (const float*)KARG(16), MOD + 6 * DM, MOD + 7 * DM, XN, nullptr); if (BOTH(9)) GRID_BAR(); }
    if (IN(10)) { REFRESH();
        pg8::Gemm g{XN, (const h16*)(ws + WS_W2A), MTOK, 2 * DFF, DM}; pg8::StaticOrder S; S.init(MTOK, 2 * DFF, F.G, bx);
        EpiSwiglu E{HB};
        pg8::gemm_phase<EpiSwiglu, pg8::StaticOrder, true, true>(F.lds + RING_OFF, g, S, E, F.tid);
        if (BOTH(10)) GRID_BAR();
    }
    if (IN(11)) { REFRESH();
        pg8::Gemm g{HB, (const h16*)(ws + WS_W2B), MTOK, DM, DFF}; pg8::StaticOrder S; S.init(MTOK, DM, F.G, bx);
        EpiResid E{OUTP, OUTP, MOD + 8 * DM, 0.5f};
        pg8::gemm_phase<EpiResid, pg8::StaticOrder, true, true>(F.lds + RING_OFF, g, S, E, F.tid);
        if (BOTH(11)) GRID_BAR();
    }
    if (IN(12)) { REFRESH(); norm_rows<1>(F, OUTP, (const float*)KARG(19), nullptr, nullptr, nullptr, OUTP); }
#undef IN
#undef BOTH
#undef XIN
#undef OUTP
#undef KARG
}

extern "C" void kernel_launch(void* const* d_in, const int* in_sizes, int n_in, void* d_out, int out_size, void* d_ws, size_t ws_size, hipStream_t stream) {
    static int grid = 0;
    if (grid == 0) {
        if (n_in != 20 || in_sizes[0] != MTOK * DM || out_size != MTOK * DM || ws_size < WS_END) { fprintf(stderr, "kernel_launch: unexpected shapes (n_in %d, in0 %d, out %d, ws %zu); nothing launched\n", n_in, n_in > 0 ? in_sizes[0] : -1, out_size, ws_size); grid = -1; return; }
        int dev = 0, cus = 0, per_cu = 0;
        if (hipGetDevice(&dev) != hipSuccess || hipDeviceGetAttribute(&cus, hipDeviceAttributeMultiprocessorCount, dev) != hipSuccess) { grid = -1; return; }
        if (hipFuncSetAttribute((const void*)mega_fwd, hipFuncAttributeMaxDynamicSharedMemorySize, LDS_BYTES) != hipSuccess) { fprintf(stderr, "kernel_launch: hipFuncSetAttribute failed\n"); grid = -1; return; }
        if (hipOccupancyMaxActiveBlocksPerMultiprocessor(&per_cu, (const void*)mega_fwd, NWAVES * 64, LDS_BYTES) != hipSuccess || per_cu < 1) fprintf(stderr, "kernel_launch: occupancy query says %d\n", per_cu);
        (void)hipGetLastError();
        grid = cus;
    }
    if (grid < 0) return;
    if (hipMemsetAsync((char*)d_ws + WS_CTL, 0, CTL_ZERO_BYTES, stream) != hipSuccess) return;
    Args a{};
    for (int i = 0; i < 20; ++i) a.in[i] = d_in[i];
    a.out = (float*)d_out; a.ws = (unsigned char*)d_ws;
#if MK_SPLIT
    for (int p = 0; p < N_PHASES; ++p) { a.ph_lo = p; a.ph_hi = p + 1; hipLaunchKernelGGL(mega_fwd, dim3(grid), dim3(NWAVES * 64), LDS_BYTES, stream, a); }
#else
    a.ph_lo = 0; a.ph_hi = N_PHASES;
    hipLaunchKernelGGL(mega_fwd, dim3(grid), dim3(NWAVES * 64), LDS_BYTES, stream, a);
#endif
}
```
